# Optimizing an MI355X kernel written in HIP

```python
import jax, jax.numpy as jnp
from jax import lax
import numpy as np

D_MODEL = 2048
BATCH = 16
SEQ = 256
DEPTH = 4
DEC_BATCH = 4
DEC_SEQ = 1024
PAST_LEN = 256

GRID_W = 64
HD = 128
EPS = 1e-6
NEG = -1e30
ROPE_THETA = 10000.0
CHUNK = 64
QBLK = 128
H_A = 8
DK_A = 128
DV_A = 128
W_A = H_A * DV_A
CONV_K = 5
H_B = 8
HKV_B = 2
W_B = H_B * HD
WIN = 128
H_C = 4
DK_C = 128
DV_C = 256
QK_C = H_C * DK_C
W_C = H_C * DV_C
GLA_RANK = 16
GLA_TAU = 16.0
H_D = 8
W_D = H_D * HD
NB_H = 8
NB_W = 16
NB_CBLK = 16
NB_CSPAN = 32

N_EVEN = (DEPTH + 1) // 2
N_ODD = DEPTH // 2
PA_EVEN = 4 * W_A + 4 * H_A
P_EVEN = PA_EVEN + 2 * W_B + 2 * HKV_B * HD
PC_ODD = 2 * QK_C + 2 * W_C + 2 * GLA_RANK
P_ODD = PC_ODD + 4 * W_D
MIX_EVEN = W_A + W_B
MIX_ODD = W_C + W_D
F32 = jnp.float32

kernel_name = 'hybrid_flow_backbone_step'


def rmsnorm(x, w):
    xf = x.astype(F32)
    y = xf * lax.rsqrt(jnp.mean(xf * xf, -1, keepdims=True) + EPS)
    return (y * w.astype(F32)).astype(x.dtype)


def l2norm(x):
    xf = x.astype(F32)
    return xf * lax.rsqrt(jnp.sum(xf * xf, -1, keepdims=True) + EPS)


def adaln(x, cond, norm_w, w_ada, b_ada):
    mod = jax.nn.silu(cond) @ w_ada + b_ada
    shift, scale, gate = jnp.split(mod, 3, axis=-1)
    return rmsnorm(x, norm_w) * (1 + scale) + shift, gate


def rope_axis(x, pos):
    half = x.shape[-1] // 2
    freq = ROPE_THETA ** (-jnp.arange(half, dtype=F32) / half)
    ang = pos.astype(F32)[:, None] * freq[None, :]
    cos, sin = jnp.cos(ang)[:, None, :], jnp.sin(ang)[:, None, :]
    x1, x2 = x[..., :half].astype(F32), x[..., half:].astype(F32)
    return jnp.concatenate([x1 * cos - x2 * sin, x2 * cos + x1 * sin], -1).astype(x.dtype)


def rope2d(x):
    t = jnp.arange(x.shape[1])
    h = x.shape[-1] // 2
    return jnp.concatenate([rope_axis(x[..., :h], t // GRID_W), rope_axis(x[..., h:], t % GRID_W)], -1)


def short_conv(x, w):
    pad = CONV_K // 2
    y = lax.conv_general_dilated(x, w[:, None, :].astype(x.dtype), window_strides=(1,),
                                 padding=[(pad, pad)], dimension_numbers=('NWC', 'WIO', 'NWC'),
                                 feature_group_count=x.shape[-1])
    return jax.nn.silu(y)


def attn_probs(s, sink):
    if sink is None:
        return jax.nn.softmax(s, -1)
    sk = sink.astype(F32).reshape(s.shape[1], s.shape[2])[None, :, :, None, None]
    m = jnp.maximum(jnp.max(s, -1, keepdims=True), sk)
    e = jnp.exp(s - m)
    return e / (jnp.sum(e, -1, keepdims=True) + jnp.exp(sk - m))


def dense_attn(q, k, v, sink):
    B_, L, H, D = q.shape
    Hkv = k.shape[2]
    G = H // Hkv
    qb = q.reshape(B_, L // QBLK, QBLK, Hkv, G, D).transpose(1, 0, 2, 3, 4, 5)
    scale = D ** -0.5

    def blk(qi):
        s = jnp.einsum('bqkgd,bskd->bkgqs', qi, k).astype(F32) * scale
        p = attn_probs(s, sink).astype(v.dtype)
        return jnp.einsum('bkgqs,bskd->bqkgd', p, v)

    o = lax.map(blk, qb)
    return o.transpose(1, 0, 2, 3, 4, 5).reshape(B_, L, H * D)


def windowed_attn(q, k, v, kc, vc, sink):
    B_, L, H, D = q.shape
    Hkv = k.shape[2]
    G = H // Hkv
    nq = L // QBLK
    span = QBLK + 2 * WIN
    pad = ((0, 0), (WIN, WIN), (0, 0), (0, 0))
    kp, vp = jnp.pad(k, pad), jnp.pad(v, pad)
    qb = q.reshape(B_, nq, QBLK, Hkv, G, D).transpose(1, 0, 2, 3, 4, 5)
    scale = D ** -0.5

    def blk(args):
        i, qi = args
        kw = lax.dynamic_slice_in_dim(kp, i * QBLK, span, axis=1)
        vw = lax.dynamic_slice_in_dim(vp, i * QBLK, span, axis=1)
        qpos = i * QBLK + jnp.arange(QBLK)
        kpos = i * QBLK - WIN + jnp.arange(span)
        ok = (jnp.abs(qpos[:, None] - kpos[None, :]) <= WIN) & (kpos >= 0)[None, :] & (kpos < L)[None, :]
        s_w = jnp.where(ok, jnp.einsum('bqkgd,bskd->bkgqs', qi, kw).astype(F32) * scale, NEG)
        s_c = jnp.einsum('bqkgd,bskd->bkgqs', qi, kc).astype(F32) * scale
        p = attn_probs(jnp.concatenate([s_w, s_c], -1), sink).astype(v.dtype)
        return (jnp.einsum('bkgqs,bskd->bqkgd', p[..., :span], vw)
                + jnp.einsum('bkgqs,bskd->bqkgd', p[..., span:], vc))

    o = lax.map(blk, (jnp.arange(nq), qb))
    return o.transpose(1, 0, 2, 3, 4, 5).reshape(B_, L, H * D)


def neighbourhood_attn(q, k, v, kc, vc, rpb):
    B_, L, H, D = q.shape
    rows = L // GRID_W
    kh = min(NB_H, rows)
    ncb = GRID_W // NB_CBLK
    qcol = np.arange(GRID_W).reshape(ncb, NB_CBLK)
    cstart = np.clip(qcol - NB_W // 2, 0, GRID_W - NB_W)
    cs0 = np.clip(np.arange(ncb) * NB_CBLK - NB_W // 2, 0, GRID_W - NB_CSPAN)
    kcol = cs0[:, None] + np.arange(NB_CSPAN)
    col_ok = (kcol[:, None, :] >= cstart[:, :, None]) & (kcol[:, None, :] < cstart[:, :, None] + NB_W)
    dc_idx = np.clip(kcol[:, None, :] - qcol[:, :, None], -(NB_W - 1), NB_W - 1) + NB_W - 1
    scale = D ** -0.5
    kg = k.reshape(B_, rows, GRID_W, H, D)
    vg = v.reshape(B_, rows, GRID_W, H, D)
    qg = q.reshape(B_, rows, ncb, NB_CBLK, H, D).transpose(1, 0, 2, 3, 4, 5)
    nk = kh * NB_CSPAN

    def row_blk(args):
        r, qr = args
        rs = jnp.clip(r - kh // 2, 0, rows - kh)
        kb = lax.dynamic_slice_in_dim(kg, rs, kh, axis=1)[:, :, kcol]
        vb = lax.dynamic_slice_in_dim(vg, rs, kh, axis=1)[:, :, kcol]
        dr_idx = rs + jnp.arange(kh) - r + NB_H - 1
        bias = rpb[:, dr_idx][:, :, dc_idx].transpose(0, 2, 3, 1, 4).astype(F32)
        s_n = jnp.einsum('bjqhd,bkjshd->bhjqks', qr, kb).astype(F32) * scale + bias[None]
        s_n = jnp.where(col_ok[:, :, None, :], s_n, NEG).reshape(B_, H, ncb, NB_CBLK, nk)
        s_c = jnp.einsum('bjqhd,bshd->bhjqs', qr, kc).astype(F32) * scale
        p = jax.nn.softmax(jnp.concatenate([s_n, s_c], -1), -1).astype(v.dtype)
        pn = p[..., :nk].reshape(B_, H, ncb, NB_CBLK, kh, NB_CSPAN)
        return (jnp.einsum('bhjqks,bkjshd->bjqhd', pn, vb)
                + jnp.einsum('bhjqs,bshd->bjqhd', p[..., nk:], vc))

    o = lax.map(row_blk, (jnp.arange(rows), qg))
    return o.transpose(1, 0, 2, 3, 4, 5).reshape(B_, L, H * D)


def delta_chunked(q, k, v, g, beta, s0):
    B_, H, L, _ = q.shape
    n = L // CHUNK
    ck = lambda t: t.reshape(B_, H, n, CHUNK, *t.shape[3:])
    q, k, v, g, beta = ck(q), ck(k), ck(v), ck(g), ck(beta)
    gc = jnp.cumsum(g, -1)
    tri = jnp.tril(jnp.ones((CHUNK, CHUNK), bool))
    strict = jnp.tril(jnp.ones((CHUNK, CHUNK), bool), -1)
    decay = jnp.exp(jnp.where(tri, gc[..., :, None] - gc[..., None, :], NEG))
    kb = k * beta[..., None]
    lmat = jnp.where(strict, jnp.einsum('bhncd,bhnsd->bhncs', kb, k) * decay, 0.0)
    tmat = lmat + jnp.eye(CHUNK, dtype=F32)
    u = lax.linalg.triangular_solve(tmat, v * beta[..., None], left_side=True, lower=True, unit_diagonal=True)
    w = lax.linalg.triangular_solve(tmat, kb * jnp.exp(gc)[..., None], left_side=True, lower=True, unit_diagonal=True)
    attn = jnp.where(tri, jnp.einsum('bhncd,bhnsd->bhncs', q, k) * decay, 0.0)
    mv = lambda t: jnp.moveaxis(t, 2, 0)

    def step(s, xs):
        qi, ki, ui, wi, gi, ai = xs
        vn = ui - jnp.einsum('bhcd,bhde->bhce', wi, s)
        o = jnp.einsum('bhcd,bhde->bhce', qi * jnp.exp(gi)[..., None], s) + jnp.einsum('bhcs,bhse->bhce', ai, vn)
        gl = gi[..., -1]
        s = s * jnp.exp(gl)[..., None, None] + jnp.einsum('bhcd,bhce->bhde', ki * jnp.exp(gl[..., None] - gi)[..., None], vn)
        return s, o

    s, o = lax.scan(step, s0, (mv(q), mv(k), mv(u), mv(w), mv(gc), mv(attn)))
    return jnp.moveaxis(o, 0, 2).reshape(B_, H, L, -1), s


def gla_chunked(q, k, v, gk, s0):
    B_, H, L, _ = q.shape
    n = L // CHUNK
    chunks = lambda t: jnp.moveaxis(t.reshape(B_, H, n, CHUNK, t.shape[-1]), 2, 0)
    tri = jnp.tril(jnp.ones((CHUNK, CHUNK), bool))

    def step(s, xs):
        qi, ki, vi, gi = xs
        b = jnp.cumsum(gi, axis=2)
        inter = jnp.einsum('bhcd,bhde->bhce', qi * jnp.exp(b), s)
        diff = jnp.where(tri[:, :, None], b[:, :, :, None, :] - b[:, :, None, :, :], NEG)
        a = jnp.einsum('bhcd,bhsd,bhcsd->bhcs', qi, ki, jnp.exp(diff))
        intra = jnp.einsum('bhcs,bhse->bhce', a, vi)
        bl = b[:, :, -1]
        s = s * jnp.exp(bl)[..., None] + jnp.einsum('bhcd,bhce->bhde', ki * jnp.exp(bl[:, :, None] - b), vi)
        return s, inter + intra

    s, o = lax.scan(step, s0, (chunks(q), chunks(k), chunks(v), chunks(gk)))
    return jnp.moveaxis(o, 0, 2).reshape(B_, H, L, -1), s


def flip_seq(t):
    return jnp.flip(t, axis=2)


def mixer_delta(pa, s0, conv_w, a_log, dt_bias, onorm):
    B_, L, _ = pa.shape
    qkv = short_conv(pa[..., :3 * W_A], conv_w)
    z = pa[..., 3 * W_A:4 * W_A]
    heads = lambda t, d: t.astype(F32).reshape(B_, L, H_A, d).transpose(0, 2, 1, 3)
    q = l2norm(heads(qkv[..., :W_A], DK_A)) * DK_A ** -0.5
    k = l2norm(heads(qkv[..., W_A:2 * W_A], DK_A))
    v = heads(qkv[..., 2 * W_A:], DV_A)
    dirs = lambda t: t.astype(F32).reshape(B_, L, 2, H_A).transpose(2, 0, 3, 1)
    beta = jax.nn.sigmoid(dirs(pa[..., 4 * W_A:4 * W_A + 2 * H_A]))
    g = -jnp.exp(a_log.astype(F32))[:, None, :, None] * jax.nn.softplus(
        dirs(pa[..., 4 * W_A + 2 * H_A:]) + dt_bias.astype(F32)[:, None, :, None])
    s0 = s0.astype(F32)
    o_f, s_f = delta_chunked(q, k, v, g[0], beta[0], s0[:, 0])
    o_b, s_b = delta_chunked(flip_seq(q), flip_seq(k), flip_seq(v), flip_seq(g[1]), flip_seq(beta[1]), s0[:, 1])
    o = (o_f + flip_seq(o_b)).transpose(0, 2, 1, 3)
    o = rmsnorm(o, onorm).reshape(B_, L, W_A).astype(pa.dtype) * jax.nn.silu(z)
    return o, jnp.stack([s_f, s_b], 1).astype(pa.dtype)


def mixer_gla(pc, s0, w_glr, b_glr, onorm):
    B_, L, _ = pc.shape
    heads = lambda t, d: t.astype(F32).reshape(B_, L, H_C, d).transpose(0, 2, 1, 3)
    q = heads(pc[..., :QK_C], DK_C) * DK_C ** -0.5
    k = heads(pc[..., QK_C:2 * QK_C], DK_C)
    v = heads(pc[..., 2 * QK_C:2 * QK_C + W_C], DV_C)
    z = pc[..., 2 * QK_C + W_C:2 * QK_C + 2 * W_C]
    lr = pc[..., 2 * QK_C + 2 * W_C:].astype(F32).reshape(B_, L, 2, GLA_RANK)
    gk = jax.nn.log_sigmoid(jnp.einsum('blnr,nrd->nbld', lr, w_glr.astype(F32))
                            + b_glr.astype(F32)[:, None, None, :]) / GLA_TAU
    gk = gk.reshape(2, B_, L, H_C, DK_C).transpose(0, 1, 3, 2, 4)
    s0 = s0.astype(F32)
    o_f, s_f = gla_chunked(q, k, v, gk[0], s0[:, 0])
    o_b, s_b = gla_chunked(flip_seq(q), flip_seq(k), flip_seq(v), flip_seq(gk[1]), s0[:, 1])
    o = (o_f + flip_seq(o_b)).transpose(0, 2, 1, 3)
    o = rmsnorm(o, onorm).reshape(B_, L, W_C).astype(pc.dtype) * jax.nn.silu(z)
    return o, jnp.stack([s_f, s_b], 1).astype(pc.dtype)


def even_layer(h, w_in, conv_w, a_log, dt_bias, onorm, sink, s0, ctx_kv):
    B_, L, _ = h.shape
    p = h @ w_in
    o_a, st = mixer_delta(p[..., :PA_EVEN], s0, conv_w, a_log, dt_bias, onorm)
    pb = p[..., PA_EVEN:]
    q = pb[..., :W_B].reshape(B_, L, H_B, HD)
    k = pb[..., W_B:W_B + HKV_B * HD].reshape(B_, L, HKV_B, HD)
    v = pb[..., W_B + HKV_B * HD:W_B + 2 * HKV_B * HD].reshape(B_, L, HKV_B, HD)
    z = pb[..., W_B + 2 * HKV_B * HD:]
    if ctx_kv is None:
        o_b = dense_attn(q, k, v, sink)
        kv = jnp.stack([k, v], 1)
    else:
        o_b = windowed_attn(rope2d(q), rope2d(k), v, ctx_kv[:, 0], ctx_kv[:, 1], sink)
        kv = None
    o_b = o_b * jax.nn.silu(z)
    return jnp.concatenate([o_a, o_b], -1), st, kv


def odd_layer(h, w_in, w_glr, b_glr, onorm, rpb, s0, ctx_kv):
    B_, L, _ = h.shape
    p = h @ w_in
    o_c, st = mixer_gla(p[..., :PC_ODD], s0, w_glr, b_glr, onorm)
    pd = p[..., PC_ODD:]
    q = pd[..., :W_D].reshape(B_, L, H_D, HD)
    k = pd[..., W_D:2 * W_D].reshape(B_, L, H_D, HD)
    v = pd[..., 2 * W_D:3 * W_D].reshape(B_, L, H_D, HD)
    z = pd[..., 3 * W_D:]
    if ctx_kv is None:
        o_d = dense_attn(q, k, v, None)
        kv = jnp.stack([k, v], 1)
    else:
        o_d = neighbourhood_attn(q, k, v, ctx_kv[:, 0], ctx_kv[:, 1], rpb)
        kv = None
    o_d = o_d * jax.nn.silu(z)
    return jnp.concatenate([o_c, o_d], -1), st, kv


def setup_inputs(seed: int = 0) -> dict:
    key = jax.random.key(seed)
    ks = jax.random.split(key, 25)
    nrm = lambda i, shape, s: jax.random.normal(ks[i], shape, F32) * s
    dt = jnp.exp(jax.random.uniform(ks[14], (N_EVEN, 2, H_A), F32, np.log(1e-3), np.log(1e-1)))
    return {
        'x_prompt': nrm(0, (BATCH, SEQ, D_MODEL), 1.0),
        'x_sample': nrm(1, (DEC_BATCH, DEC_SEQ, D_MODEL), 1.0),
        'state_delta': nrm(2, (DEC_BATCH, N_EVEN, 2, H_A, DK_A, DV_A), 0.1),
        'cache_kv_win': nrm(3, (DEC_BATCH, N_EVEN, 2, PAST_LEN, HKV_B, HD), 1.0),
        'state_gla': nrm(4, (DEC_BATCH, N_ODD, 2, H_C, DK_C, DV_C), 0.1),
        'cache_kv_nbr': nrm(5, (DEC_BATCH, N_ODD, 2, PAST_LEN, H_D, HD), 1.0),
        'c': nrm(6, (DEC_BATCH, D_MODEL), 1.0),
        'c_ctx': nrm(7, (D_MODEL,), 1.0),
        'norm_w': 1.0 + nrm(8, (DEPTH, D_MODEL), 0.02),
        'w_ada': nrm(9, (DEPTH, D_MODEL, 3 * D_MODEL), 0.5 * D_MODEL ** -0.5),
        'b_ada': nrm(10, (DEPTH, 3 * D_MODEL), 0.02),
        'w_in_even': nrm(11, (N_EVEN, D_MODEL, P_EVEN), D_MODEL ** -0.5),
        'conv_a': nrm(12, (N_EVEN, CONV_K, 3 * W_A), CONV_K ** -0.5),
        'a_log_a': jnp.log(jax.random.uniform(ks[13], (N_EVEN, 2, H_A), F32, 1.0, 16.0)),
        'dt_bias_a': jnp.log(jnp.expm1(dt)),
        'onorm_a': 1.0 + nrm(15, (N_EVEN, DV_A), 0.02),
        'sink_b': nrm(16, (N_EVEN, H_B), 1.0),
        'w_out_even': nrm(17, (N_EVEN, MIX_EVEN, D_MODEL), MIX_EVEN ** -0.5),
        'w_in_odd': nrm(18, (N_ODD, D_MODEL, P_ODD), D_MODEL ** -0.5),
        'w_glr_c': nrm(19, (N_ODD, 2, GLA_RANK, QK_C), GLA_RANK ** -0.5),
        'b_glr_c': nrm(20, (N_ODD, 2, QK_C), 0.1),
        'onorm_c': 1.0 + nrm(21, (N_ODD, DV_C), 0.02),
        'rpb_d': nrm(22, (N_ODD, H_D, 2 * NB_H - 1, 2 * NB_W - 1), 0.2),
        'w_out_odd': nrm(23, (N_ODD, MIX_ODD, D_MODEL), MIX_ODD ** -0.5),
        'final_norm_w': 1.0 + nrm(24, (D_MODEL,), 0.02),
    }


def reference(x_prompt, x_sample, state_delta, cache_kv_win, state_gla, cache_kv_nbr, c, c_ctx,
              norm_w, w_ada, b_ada, w_in_even, conv_a, a_log_a, dt_bias_a, onorm_a, sink_b, w_out_even,
              w_in_odd, w_glr_c, b_glr_c, onorm_c, rpb_d, w_out_odd, final_norm_w):
    xc, xl = x_prompt, x_sample
    cc = c_ctx[None, None, :]
    cl = c[:, None, :]
    bc = x_prompt.shape[0]
    new_delta, new_kvw, new_gla, new_kvn = [], [], [], []
    for li in range(DEPTH):
        hc, gate_c = adaln(xc, cc, norm_w[li], w_ada[li], b_ada[li])
        hl, gate_l = adaln(xl, cl, norm_w[li], w_ada[li], b_ada[li])
        if li % 2 == 0:
            e = li // 2
            prm = (w_in_even[e], conv_a[e], a_log_a[e], dt_bias_a[e], onorm_a[e], sink_b[e])
            s_zero = jnp.zeros((bc, 2, H_A, DK_A, DV_A), F32)
            oc, st, kv = even_layer(hc, *prm, s_zero, None)
            ol, _, _ = even_layer(hl, *prm, state_delta[:, e], cache_kv_win[:, e])
            new_delta.append(st)
            new_kvw.append(kv)
            w_out = w_out_even[e]
        else:
            o_i = li // 2
            prm = (w_in_odd[o_i], w_glr_c[o_i], b_glr_c[o_i], onorm_c[o_i], rpb_d[o_i])
            s_zero = jnp.zeros((bc, 2, H_C, DK_C, DV_C), F32)
            oc, st, kv = odd_layer(hc, *prm, s_zero, None)
            ol, _, _ = odd_layer(hl, *prm, state_gla[:, o_i], cache_kv_nbr[:, o_i])
            new_gla.append(st)
            new_kvn.append(kv)
            w_out = w_out_odd[o_i]
        xc = xc + gate_c * (oc @ w_out)
        xl = xl + gate_l * (ol @ w_out)
    y_prompt = rmsnorm(xc, final_norm_w)
    y_sample = rmsnorm(xl, final_norm_w)
    return (y_prompt, y_sample, jnp.stack(new_delta, 1), jnp.stack(new_kvw, 1),
            jnp.stack(new_gla, 1), jnp.stack(new_kvn, 1))
```

```cpp
#include <hip/hip_runtime.h>
#include <hip/hip_cooperative_groups.h>
#include <cstdio>
#include <cstdint>
namespace cg = cooperative_groups;

namespace pg8 {
#define PG8_LAS __attribute__((address_space(3)))
typedef unsigned short bf16_t;
typedef short bf16x8 __attribute__((ext_vector_type(8)));
typedef float f32x4 __attribute__((ext_vector_type(4)));
typedef unsigned u32x4 __attribute__((ext_vector_type(4)));
constexpr int BM = 256, BK = 64, HALF = 128, HTB = HALF * BK * 2  , STAGE_BYTES = 8 * HTB, NXCD = 8, WGM = 8;

__host__ __device__ __forceinline__ int lds_byte(int r, int c) { const int st = (r >> 4) * 2 + (c >> 5), rr = r & 15, cc = c & 31, ob = rr * 64 + cc * 2; return st * 1024 + (ob ^ (((ob >> 9) & 1) << 5)); }
__host__ __device__ __forceinline__ void stage_rc(int b, int& R, int& C) { const int st = b / 1024, sb = b % 1024, swz = sb ^ (((sb >> 9) & 1) << 5); R = (st >> 1) * 16 + swz / 64; C = (st & 1) * 32 + (swz % 64) / 2; }
__host__ __device__ __forceinline__ int perm32(int rho) { const int n = rho >> 4, i = rho & 15; return 8 * (i >> 2) + 4 * n + (i & 3); }

struct Unit { int pm, pn; };
struct Gemm { const bf16_t* A; const bf16_t* Bt; int M, N, K; };

struct StaticOrder {
    int nM, nN, nwg, G, c;
    __host__ __device__ void init(int M, int N, int G_, int c_) { nM = M / BM; nN = N / BM; nwg = nM * nN; G = G_; c = c_; }
    __host__ __device__ bool next(int i, Unit& u) const {
        const long L = (long)i * G + c; if (L >= nwg) return false;
        int wgid = (int)L; { const int q = nwg / NXCD, r = nwg % NXCD, xcd = wgid % NXCD, off = wgid / NXCD; wgid = (xcd < r ? xcd * (q + 1) : r * (q + 1) + (xcd - r) * q) + off; }
        const int nig = WGM * nN, gid = wgid / nig, fm = gid * WGM, gsz = (nM - fm) < WGM ? (nM - fm) : WGM;
        u.pm = fm + ((wgid % nig) % gsz); u.pn = (wgid % nig) / gsz; return true;
    }
    __device__ __forceinline__ void a_ready(const Unit&) const {}
    __device__ __forceinline__ void done(const Unit&) const {}
};
__device__ __forceinline__ unsigned cvt_pk_bf16(float lo, float hi) { unsigned r; asm volatile("v_cvt_pk_bf16_f32 %0, %1, %2" : "=v"(r) : "v"(lo), "v"(hi)); return r; }
template <class Epi, class Sched, bool ALIGN_EPI = false, bool SP2 = false>
__device__ __forceinline__ void gemm_phase(PG8_LAS unsigned char* lds, const Gemm g, const Sched& S, const Epi& E) {
    int tid_l = threadIdx.x; asm volatile("" : "+v"(tid_l));
    const int tid = tid_l, wid = __builtin_amdgcn_readfirstlane(tid >> 6), lane = tid & 63, wr = wid >> 2, wc = wid & 3, fr = lane & 15, fq = lane >> 4;
    const int K = g.K, nt = K / BK;
    unsigned voffA[2], voffB[2];
#pragma unroll
    for (int i = 0; i < 2; ++i) { int R, C; stage_rc(tid * 16 + i * 8192, R, C); const int Rb = Epi::PERM ? ((R & ~31) + perm32(R & 31)) : R;
        voffA[i] = (unsigned)(R * K + C) * 2u; voffB[i] = (unsigned)(Rb * K + C) * 2u; }
    const size_t kstep = (size_t)(BK * 2);
    const size_t hstep = (size_t)HALF * K * 2;
    const size_t tstep = 2 * hstep;
    const unsigned ldsw = (unsigned)wid * 1024u;
    const int aoff = lds_byte(wr * 64 + fr, fq * 8), boff = lds_byte(wc * 32 + fr, fq * 8);
#define PG8_SA(b, h) (((b) * 2 + (h)) * HTB)
#define PG8_SB(b, h) ((4 + (b) * 2 + (h)) * HTB)
#define PG8_STAGE(bufoff, gbase, voff) do { _Pragma("unroll") for (int _i = 0; _i < 2; ++_i) \
        __builtin_amdgcn_global_load_lds((const unsigned*)((const char*)(gbase) + (voff)[_i]), (PG8_LAS unsigned*)(lds + (bufoff) + ldsw + _i * 8192), 16, 0, 0); } while (0)
#define PG8_LDA(dst, b, h) do { _Pragma("unroll") for (int m = 0; m < 4; ++m) _Pragma("unroll") for (int k = 0; k < 2; ++k) dst[m][k] = *(const PG8_LAS bf16x8*)(lds + PG8_SA(b, h) + aoff + m * 2048 + k * 1024); } while (0)
#define PG8_LDB(dst, b, h) do { _Pragma("unroll") for (int n = 0; n < 2; ++n) _Pragma("unroll") for (int k = 0; k < 2; ++k) dst[n][k] = *(const PG8_LAS bf16x8*)(lds + PG8_SB(b, h) + boff + n * 2048 + k * 1024); } while (0)
#define PG8_MMA(ai, bj, At, Bt) do { __builtin_amdgcn_s_setprio(1); _Pragma("unroll") for (int m = 0; m < 4; ++m) _Pragma("unroll") for (int n = 0; n < 2; ++n) _Pragma("unroll") for (int k = 0; k < 2; ++k) \
        acc[ai][bj][m][n] = __builtin_amdgcn_mfma_f32_16x16x32_bf16(Bt[n][k], At[m][k], acc[ai][bj][m][n], 0, 0, 0); __builtin_amdgcn_s_setprio(0); } while (0)
#define PG8_WAIT_V(n) asm volatile("s_waitcnt vmcnt(" #n ")" ::: "memory")
#define PG8_WAIT_L(n) asm volatile("s_waitcnt lgkmcnt(" #n ")" ::: "memory")
#define PG8_BAR __builtin_amdgcn_s_barrier()
#define PG8_SCHED __builtin_amdgcn_sched_barrier(0)
    Unit cur, nxt; int ui = 0;
    if (!S.next(0, cur)) return;
    f32x4 acc[2][2][4][2];
#pragma unroll
    for (int a = 0; a < 2; ++a)
#pragma unroll
        for (int b = 0; b < 2; ++b)
#pragma unroll
            for (int m = 0; m < 4; ++m)
#pragma unroll
                for (int n = 0; n < 2; ++n) acc[a][b][m][n] = (f32x4){0.f, 0.f, 0.f, 0.f};
    bf16x8 At[4][2], B0[2][2], B1[2][2];
    const char* cA = (const char*)g.A + (size_t)cur.pm * tstep; const char* cB = (const char*)g.Bt + (size_t)cur.pn * tstep;
    S.a_ready(cur);
    if constexpr (SP2) {
        PG8_STAGE(PG8_SB(0, 0), cB, voffB); PG8_STAGE(PG8_SB(0, 1), cB + hstep, voffB); PG8_STAGE(PG8_SA(0, 0), cA, voffA); PG8_STAGE(PG8_SA(0, 1), cA + hstep, voffA);
        if (wr == 1) PG8_BAR;
        PG8_WAIT_V(2); PG8_BAR;
        PG8_STAGE(PG8_SB(1, 0), cB + kstep, voffB); PG8_STAGE(PG8_SA(1, 0), cA + kstep, voffA); PG8_STAGE(PG8_SB(1, 1), cB + hstep + kstep, voffB);
        PG8_WAIT_V(6); PG8_BAR;
    } else {
        PG8_STAGE(PG8_SB(0, 0), cB, voffB); PG8_STAGE(PG8_SA(0, 0), cA, voffA); PG8_STAGE(PG8_SB(0, 1), cB + hstep, voffB); PG8_STAGE(PG8_SA(0, 1), cA + hstep, voffA);
        if (wr == 1) PG8_BAR;
        PG8_WAIT_V(4); PG8_BAR;
        PG8_STAGE(PG8_SB(1, 0), cB + kstep, voffB); PG8_STAGE(PG8_SA(1, 0), cA + kstep, voffA); PG8_STAGE(PG8_SB(1, 1), cB + hstep + kstep, voffB);
        PG8_WAIT_V(6); PG8_BAR;
    }
    for (;;) {
        const bool has_next = S.next(ui + 1, nxt);
        const char* nA = has_next ? (const char*)g.A + (size_t)nxt.pm * tstep : cA; const char* nB = has_next ? (const char*)g.Bt + (size_t)nxt.pn * tstep : cB;
        for (int t = 0; t < nt; t += 2) {
            const bool last = (t == nt - 2);
            const char* a1 = cA + (size_t)(t + 1) * kstep;
            const char* a2 = last ? nA : cA + (size_t)(t + 2) * kstep; const char* b2 = last ? nB : cB + (size_t)(t + 2) * kstep;
            const char* a3 = a2 + kstep; const char* b3 = b2 + kstep;
            if (last && has_next) S.a_ready(nxt);
            if constexpr (SP2) {
            PG8_LDB(B0, 0, 0); PG8_LDB(B1, 0, 1); PG8_SCHED; PG8_LDA(At, 0, 0); PG8_STAGE(PG8_SA(1, 1), a1 + hstep, voffA);
            PG8_WAIT_V(8); PG8_WAIT_L(0); PG8_BAR; PG8_MMA(0, 0, At, B0); PG8_MMA(0, 1, At, B1); PG8_BAR; PG8_SCHED;
            PG8_LDA(At, 0, 1); PG8_STAGE(PG8_SB(0, 0), b2, voffB); PG8_STAGE(PG8_SB(0, 1), b2 + hstep, voffB); PG8_STAGE(PG8_SA(0, 0), a2, voffA);
            PG8_WAIT_V(8); PG8_WAIT_L(0); PG8_BAR; PG8_MMA(1, 0, At, B0); PG8_MMA(1, 1, At, B1); PG8_BAR; PG8_SCHED;
            PG8_LDB(B0, 1, 0); PG8_LDB(B1, 1, 1); PG8_SCHED; PG8_LDA(At, 1, 0); PG8_STAGE(PG8_SA(0, 1), a2 + hstep, voffA);
            PG8_WAIT_V(8); PG8_WAIT_L(0); PG8_BAR; PG8_MMA(0, 0, At, B0); PG8_MMA(0, 1, At, B1); PG8_BAR; PG8_SCHED;
            PG8_LDA(At, 1, 1); PG8_STAGE(PG8_SB(1, 0), b3, voffB); PG8_STAGE(PG8_SB(1, 1), b3 + hstep, voffB); PG8_STAGE(PG8_SA(1, 0), a3, voffA);
            PG8_WAIT_V(8); PG8_WAIT_L(0); PG8_BAR; PG8_MMA(1, 0, At, B0); PG8_MMA(1, 1, At, B1); PG8_BAR; PG8_SCHED;
            } else {
            PG8_LDB(B0, 0, 0); PG8_SCHED; PG8_LDA(At, 0, 0); PG8_STAGE(PG8_SA(1, 1), a1 + hstep, voffA);
            PG8_WAIT_L(8); PG8_BAR; PG8_WAIT_L(0); PG8_MMA(0, 0, At, B0); PG8_BAR; PG8_SCHED;
            PG8_LDB(B1, 0, 1); PG8_STAGE(PG8_SB(0, 0), b2, voffB);
            PG8_BAR; PG8_WAIT_L(0); PG8_MMA(0, 1, At, B1); PG8_BAR;
            PG8_LDA(At, 0, 1); PG8_STAGE(PG8_SA(0, 0), a2, voffA);
            PG8_BAR; PG8_WAIT_L(0); PG8_MMA(1, 0, At, B0); PG8_BAR; PG8_SCHED;
            PG8_STAGE(PG8_SB(0, 1), b2 + hstep, voffB);
            PG8_WAIT_V(6); PG8_BAR; PG8_MMA(1, 1, At, B1); PG8_BAR;
            PG8_LDB(B0, 1, 0); PG8_SCHED; PG8_LDA(At, 1, 0); PG8_STAGE(PG8_SA(0, 1), a2 + hstep, voffA);
            PG8_WAIT_L(8); PG8_BAR; PG8_WAIT_L(0); PG8_MMA(0, 0, At, B0); PG8_BAR; PG8_SCHED;
            PG8_LDB(B1, 1, 1); PG8_STAGE(PG8_SB(1, 0), b3, voffB);
            PG8_BAR; PG8_WAIT_L(0); PG8_MMA(0, 1, At, B1); PG8_BAR;
            PG8_LDA(At, 1, 1); PG8_STAGE(PG8_SA(1, 0), a3, voffA);
            PG8_BAR; PG8_WAIT_L(0); PG8_MMA(1, 0, At, B0); PG8_BAR; PG8_SCHED;
            PG8_STAGE(PG8_SB(1, 1), b3 + hstep, voffB);
            PG8_WAIT_V(6); PG8_BAR; PG8_MMA(1, 1, At, B1); PG8_BAR;
            }
        }
        if constexpr (ALIGN_EPI) { if (wr == 0) PG8_BAR; }
        if constexpr (!Epi::AFTER_DRAIN) { E(acc, cur, wr, wc, fr, fq); S.done(cur); }
        if (!has_next) break;
#pragma unroll
        for (int a = 0; a < 2; ++a)
#pragma unroll
            for (int b = 0; b < 2; ++b)
#pragma unroll
                for (int m = 0; m < 4; ++m)
#pragma unroll
                    for (int n = 0; n < 2; ++n) acc[a][b][m][n] = (f32x4){0.f, 0.f, 0.f, 0.f};
        cur = nxt; cA = nA; cB = nB; ++ui;
        if constexpr (ALIGN_EPI) { if (wr == 1) PG8_BAR; }
    }
    PG8_WAIT_V(0);
    if constexpr (!ALIGN_EPI) { if (wr == 0) PG8_BAR; }
    PG8_BAR;
    if constexpr (Epi::AFTER_DRAIN) { E.fused(acc, cur, wr, wc, fr, fq, lds, wid, lane); S.done(cur); }
#undef PG8_SA
#undef PG8_SB
#undef PG8_STAGE
#undef PG8_LDA
#undef PG8_LDB
#undef PG8_MMA
#undef PG8_WAIT_V
#undef PG8_WAIT_L
#undef PG8_BAR
#undef PG8_SCHED
}

struct EpiInProj {
    static constexpr bool PERM = true, AFTER_DRAIN = false;
    bf16_t* P; int ldp; float* SM; int last_pn;
    __device__ __forceinline__ void operator()(const f32x4 (&acc)[2][2][4][2], const Unit& u, int wr, int wc, int fr, int fq) const {
        const int row0 = u.pm * BM + wr * 64 + fr;
        if (u.pn == last_pn) {
            if (wc == 0) {
#pragma unroll
                for (int ai = 0; ai < 2; ++ai)
#pragma unroll
                    for (int m = 0; m < 4; ++m) { float* rp = SM + (size_t)(row0 + ai * HALF + m * 16) * 32 + 8 * fq;
                        *(f32x4*)(rp) = acc[ai][0][m][0]; *(f32x4*)(rp + 4) = acc[ai][0][m][1]; }
            }
            return;
        }
        const int col0 = u.pn * BM + wc * 32 + 8 * fq;
#pragma unroll
        for (int ai = 0; ai < 2; ++ai)
#pragma unroll
            for (int m = 0; m < 4; ++m) { bf16_t* rowp = P + (size_t)(row0 + ai * HALF + m * 16) * ldp + col0;
#pragma unroll
                for (int bj = 0; bj < 2; ++bj) { const f32x4 v0 = acc[ai][bj][m][0], v1 = acc[ai][bj][m][1];
                    u32x4 w; w.x = cvt_pk_bf16(v0[0], v0[1]); w.y = cvt_pk_bf16(v0[2], v0[3]); w.z = cvt_pk_bf16(v1[0], v1[1]); w.w = cvt_pk_bf16(v1[2], v1[3]);
                    *(u32x4*)(rowp + bj * HALF) = w; } }
    }
};
struct EpiOutProj {
    static constexpr bool PERM = false, AFTER_DRAIN = false;
    const float* srcC; const float* srcL; float* X; const float* gate;
    __device__ __forceinline__ void operator()(const f32x4 (&acc)[2][2][4][2], const Unit& u, int wr, int wc, int fr, int fq) const {
        const int row0 = u.pm * BM + wr * 64 + fr, col0 = u.pn * BM + wc * 32 + 4 * fq;
        const int cond = (u.pm < 16) ? 0 : 1 + ((u.pm - 16) >> 2);
        const float* gp = gate + (size_t)cond * 6144 + col0;
        const float* sp = (u.pm < 16) ? srcC : (srcL - (size_t)4096 * 2048);
        f32x4 gv[2][2];
#pragma unroll
        for (int bj = 0; bj < 2; ++bj)
#pragma unroll
            for (int n = 0; n < 2; ++n) gv[bj][n] = *(const f32x4*)(gp + bj * HALF + n * 16);
#pragma unroll
        for (int ai = 0; ai < 2; ++ai)
#pragma unroll
            for (int m = 0; m < 4; ++m) { const size_t ro = (size_t)(row0 + ai * HALF + m * 16) * 2048 + col0;
#pragma unroll
                for (int bj = 0; bj < 2; ++bj)
#pragma unroll
                    for (int n = 0; n < 2; ++n) { const f32x4 xo = *(const f32x4*)(sp + ro + bj * HALF + n * 16);
                        *(f32x4*)(X + ro + bj * HALF + n * 16) = xo + gv[bj][n] * acc[ai][bj][m][n]; } }
    }
};
struct SubsetOrder : StaticOrder {
    int odd;
    __device__ __forceinline__ bool next(int i, Unit& u) const {
        if (!StaticOrder::next(i, u)) return false;
        const int p = u.pn; u.pn = odd ? (p < 8 ? p : (p < 20 ? p + 4 : p + 5)) : (p < 12 ? p : p + 3); return true; }
};
struct SingleOrder {
    int pm, pn;
    __device__ __forceinline__ bool next(int i, Unit& u) const { if (i != 0) return false; u.pm = pm; u.pn = pn; return true; }
    __device__ __forceinline__ void a_ready(const Unit&) const {}
    __device__ __forceinline__ void done(const Unit&) const {}
};
}

typedef unsigned short bf16;
typedef short bf16x8 __attribute__((ext_vector_type(8)));
typedef float f32x4 __attribute__((ext_vector_type(4)));
typedef unsigned u32x4 __attribute__((ext_vector_type(4)));
typedef unsigned u32x2 __attribute__((ext_vector_type(2)));
#define LAS __attribute__((address_space(3)))

constexpr int DM = 2048, MCTX = 4096, MROWS = 8192;
constexpr int NP_E = 6912, LDP_E = 6656, NP_O = 7424, LDP_O = 7168;
constexpr int E_QA = 0, E_KA = 1024, E_VA = 2048, E_ZA = 3072, E_QB = 4096, E_KB = 5120, E_VB = 5376, E_ZB = 5632;
constexpr int O_QC = 0, O_KC = 512, O_VC = 1024, O_ZC = 2048, O_QD = 3072, O_KD = 4096, O_VD = 5120, O_ZD = 6144;
constexpr float EPSF = 1e-6f;
constexpr float ATT_SCALE = 0.08838834764831845f;
constexpr int NWAVES = 8, NTHREADS = 512;

constexpr size_t MiB = 1u << 20;
constexpr size_t WS_CTL = 0, CTL_ZERO_BYTES = 1 * MiB;
constexpr size_t WS_MOD = 1 * MiB;
constexpr size_t WS_WIN_E = 2 * MiB, WIN_E_BYTES = (size_t)NP_E * DM * 2;
constexpr size_t WS_WIN_O = 56 * MiB, WIN_O_BYTES = (size_t)NP_O * DM * 2;
constexpr size_t WS_WOUT = 114 * MiB, WOUT_BYTES = (size_t)DM * DM * 2;
constexpr size_t WS_X = 146 * MiB;
constexpr size_t WS_H = 210 * MiB;
constexpr size_t WS_OMIX = 242 * MiB;
constexpr size_t WS_P = 274 * MiB;
constexpr size_t WS_SM = 386 * MiB;
constexpr size_t WS_OF = 388 * MiB, WS_OB = 420 * MiB;
constexpr size_t WS_QR = 452 * MiB, WS_KR = 460 * MiB;
constexpr size_t WS_PREP = 462 * MiB;
constexpr size_t WS_DW = WS_PREP, WS_DU = WS_DW + 112 * MiB, WS_DG = WS_DU + 64 * MiB;
constexpr size_t WS_GO = WS_PREP, WS_GV = WS_GO + 42 * MiB;
constexpr size_t WS_TCACHE_E = WS_DG + 1 * MiB;
constexpr size_t WS_TCACHE_O = WS_TCACHE_E + 2 * MiB;
constexpr size_t WS_TCTX = WS_TCACHE_O + 8 * MiB;
constexpr size_t WS_TLAT = WS_TCTX + 16 * MiB;
constexpr size_t WS_ROPE = WS_TLAT + 16 * MiB;
constexpr size_t WS_END = WS_ROPE + 1 * MiB;
static_assert(WS_WIN_E + 2 * WIN_E_BYTES <= WS_WIN_O && WS_WIN_O + 2 * WIN_O_BYTES <= WS_WOUT && WS_WOUT + 4 * WOUT_BYTES <= WS_X, "ws map");
static_assert(WS_GV + 16 * MiB <= WS_END, "ws map");

constexpr int LDS_BYTES = 147456;
constexpr int LDS_MISC = 144 * 1024 - 256;

constexpr size_t OUT_Y = 0, OUT_SD = 16777216, OUT_KVW = 25165824, OUT_SG = 29360128, OUT_KVN = 37748736, OUT_TOTAL = 54525952;

struct Args {
    const float* in[25];
    float* out; unsigned char* ws;
    int ph_lo, ph_hi, coop, pad;
};

struct Frame {
    LAS unsigned char* lds;
    unsigned char* smem;
    int tid, G, bid;
    const float* const* in;
    float* out; unsigned char* ws;
};


#define FRESH_IDS() int tid = F.tid; asm volatile("" : "+v"(tid)); const int lane = tid & 63; const int wave = __builtin_amdgcn_readfirstlane(tid >> 6); (void)lane; (void)wave;
__device__ __forceinline__ float bf2f(unsigned h) { return __builtin_bit_cast(float, h << 16); }
typedef float f32x2_t __attribute__((ext_vector_type(2))); typedef __bf16 bf16x2_t __attribute__((ext_vector_type(2)));
__device__ __forceinline__ unsigned pk2(float lo, float hi) { f32x2_t v = {lo, hi}; bf16x2_t b = __builtin_convertvector(v, bf16x2_t); return __builtin_bit_cast(unsigned, b); }
__device__ __forceinline__ unsigned f2bf(float f) { return pk2(f, 0.f) & 0xffffu; }
template <int CTRL> __device__ __forceinline__ float dpp_mov(float v) { return __builtin_bit_cast(float, __builtin_amdgcn_update_dpp(0, __builtin_bit_cast(int, v), CTRL, 0xf, 0xf, false)); }
template <int MASK> __device__ __forceinline__ void xswap(float v, float& r0, float& r1) {
    unsigned a = __builtin_bit_cast(unsigned, v), b = a;
    if constexpr (MASK == 16) asm volatile("s_nop 1\n\tv_permlane16_swap_b32 %0, %1" : "+v"(a), "+v"(b));
    else asm volatile("s_nop 1\n\tv_permlane32_swap_b32 %0, %1" : "+v"(a), "+v"(b));
    r0 = __builtin_bit_cast(float, a); r1 = __builtin_bit_cast(float, b);
}
template <int MASK> __device__ __forceinline__ float xsum(float v) {
    if constexpr (MASK == 1) return v + dpp_mov<0xB1>(v);
    else if constexpr (MASK == 2) return v + dpp_mov<0x4E>(v);
    else if constexpr (MASK == 4) return v + dpp_mov<0x141>(v);
    else if constexpr (MASK == 8) return v + dpp_mov<0x140>(v);
    else { float r0, r1; xswap<MASK>(v, r0, r1); return r0 + r1; }
}
template <int MASK> __device__ __forceinline__ float xmax(float v) { float r0, r1; xswap<MASK>(v, r0, r1); return fmaxf(r0, r1); }
__device__ __forceinline__ float wave_sum(float v) { v = xsum<1>(v); v = xsum<2>(v); v = xsum<4>(v); v = xsum<8>(v); v = xsum<16>(v); return xsum<32>(v); }
__device__ __forceinline__ float siluf(float v) { return v * __builtin_amdgcn_rcpf(1.f + __expf(-v)); }
__device__ __forceinline__ float sigmoidf_(float v) { return __builtin_amdgcn_rcpf(1.f + __expf(-v)); }
__device__ __forceinline__ float softplusf_(float v) { return fmaxf(v, 0.f) + __logf(1.f + __expf(-fabsf(v))); }
__device__ __forceinline__ float logsigmoidf_(float v) { return fminf(v, 0.f) - __logf(1.f + __expf(-fabsf(v))); }
__device__ __forceinline__ int kinv32(int e) { return 8 * ((e >> 2) & 3) + 4 * (e >> 4) + (e & 3); }
__device__ __forceinline__ f32x4 mfma16(bf16x8 a, bf16x8 b, f32x4 c) { return __builtin_amdgcn_mfma_f32_16x16x32_bf16(a, b, c, 0, 0, 0); }
__device__ __forceinline__ bf16x8 pack_acc(f32x4 lo, f32x4 hi) {
    u32x4 w; w.x = pk2(lo[0], lo[1]); w.y = pk2(lo[2], lo[3]); w.z = pk2(hi[0], hi[1]); w.w = pk2(hi[2], hi[3]);
    return __builtin_bit_cast(bf16x8, w);
}
__device__ __forceinline__ bf16x8 ld8(const bf16* p) { return *(const bf16x8*)p; }
__device__ __forceinline__ bf16x8 ld8_f32(const float* p) {
    const f32x4 a = *(const f32x4*)p, b = *(const f32x4*)(p + 4);
    u32x4 w; w.x = pk2(a[0], a[1]); w.y = pk2(a[2], a[3]); w.z = pk2(b[0], b[1]); w.w = pk2(b[2], b[3]);
    return __builtin_bit_cast(bf16x8, w);
}
__device__ __forceinline__ void seq_of_row(int m, int& s0, int& L) { if (m < MCTX) { s0 = m & ~255; L = 256; } else { s0 = MCTX + ((m - MCTX) & ~1023); L = 1024; } }
__device__ __forceinline__ int cond_of_row(int m) { return (m < MCTX) ? 0 : 1 + ((m - MCTX) >> 10); }

__device__ __forceinline__ void transpose_item(const float* W, int K, int N, bf16* WT, int k0, int n0, int drow0, float* scr, int lane) {
    const int r8 = lane >> 3, c4 = lane & 7;
    f32x4 v[8];
#pragma unroll
    for (int i = 0; i < 8; ++i) v[i] = *(const f32x4*)(W + (size_t)(k0 + 8 * i + r8) * N + n0 + 4 * c4);
#pragma unroll
    for (int i = 0; i < 8; ++i) { float* s = scr + (8 * i + r8) * 33 + 4 * c4; s[0] = v[i][0]; s[1] = v[i][1]; s[2] = v[i][2]; s[3] = v[i][3]; }
    asm volatile("s_waitcnt lgkmcnt(0)" ::: "memory");
    const int c = lane & 7;
#pragma unroll
    for (int j = 0; j < 4; ++j) { const int n = (lane >> 3) + 8 * j; const float* s = scr + (8 * c) * 33 + n;
        u32x4 o; o.x = pk2(s[0 * 33], s[1 * 33]); o.y = pk2(s[2 * 33], s[3 * 33]); o.z = pk2(s[4 * 33], s[5 * 33]); o.w = pk2(s[6 * 33], s[7 * 33]);
        *(u32x4*)(WT + (size_t)(drow0 + n) * K + k0 + 8 * c) = o; }
    asm volatile("s_waitcnt lgkmcnt(0)" ::: "memory");
}
__device__ __forceinline__ int remap_even(int n0) { return n0 < 4096 ? n0 : (n0 < 4128 ? n0 + 2560 : n0 - 32); }
__device__ __forceinline__ int remap_odd(int n0) { return n0 < 3072 ? n0 : (n0 < 3104 ? n0 + 4096 : n0 - 32); }

__device__ __forceinline__ void phase_prologue(Frame& F) {
    FRESH_IDS();
    float* scr = (float*)(F.smem + wave * 16384);
    const int gw = F.bid * NWAVES + wave, NGW = F.G * NWAVES;
    constexpr int I_E = 32 * 209, I_O = 32 * 225, I_W = 32 * 64;
    constexpr int NITEMS = 2 * I_E + 2 * I_O + 4 * I_W;
    for (int it = gw; it < NITEMS; it += NGW) {
        int r = it;
        if (r < 2 * I_E) { const int e = r / I_E; r -= e * I_E; const int kb = r / 209, nb = r % 209;
            transpose_item(F.in[11] + (size_t)e * DM * 6688, DM, 6688, (bf16*)(F.ws + WS_WIN_E + e * WIN_E_BYTES), 64 * kb, 32 * nb, remap_even(32 * nb), scr, lane); continue; }
        r -= 2 * I_E;
        if (r < 2 * I_O) { const int e = r / I_O; r -= e * I_O; const int kb = r / 225, nb = r % 225;
            transpose_item(F.in[18] + (size_t)e * DM * 7200, DM, 7200, (bf16*)(F.ws + WS_WIN_O + e * WIN_O_BYTES), 64 * kb, 32 * nb, remap_odd(32 * nb), scr, lane); continue; }
        r -= 2 * I_O;
        { const int li = r / I_W; r -= li * I_W; const int kb = r / 64, nb = r % 64;
          const float* W = (li & 1) ? F.in[23] + (size_t)(li >> 1) * DM * DM : F.in[17] + (size_t)(li >> 1) * DM * DM;
          transpose_item(W, DM, DM, (bf16*)(F.ws + WS_WOUT + li * WOUT_BYTES), 64 * kb, 32 * nb, 32 * nb, scr, lane); }
    }
    __syncthreads();
    float* scv = (float*)F.smem;
    float* red = (float*)(F.smem + 65536);
    for (int k = tid; k < DM; k += NTHREADS) {
#pragma unroll
        for (int cd = 0; cd < 5; ++cd) { const float v = (cd == 0) ? F.in[7][k] : F.in[6][(cd - 1) * DM + k]; scv[k * 8 + cd] = siluf(v); }
    }
    __syncthreads();
    float* MOD = (float*)(F.ws + WS_MOD);
    for (int unit = F.bid; unit < 384; unit += F.G) {
        const int li = unit / 96, cb = unit % 96, kr = lane >> 4, col = cb * 64 + 4 * (lane & 15);
        f32x4 acc[5];
#pragma unroll
        for (int cd = 0; cd < 5; ++cd) acc[cd] = (f32x4){0.f, 0.f, 0.f, 0.f};
        const float* wp = F.in[9] + ((size_t)li * DM + wave * 256 + kr) * 6144 + col;
#pragma unroll 8
        for (int it = 0; it < 64; ++it) {
            const f32x4 w = *(const f32x4*)(wp + (size_t)it * 4 * 6144);
            const float* sp = scv + (wave * 256 + it * 4 + kr) * 8;
            const f32x4 s4 = *(const f32x4*)sp; const float s5 = sp[4];
            acc[0] += w * s4[0]; acc[1] += w * s4[1]; acc[2] += w * s4[2]; acc[3] += w * s4[3]; acc[4] += w * s5;
        }
#pragma unroll
        for (int cd = 0; cd < 5; ++cd)
#pragma unroll
            for (int q = 0; q < 4; ++q) { float v = acc[cd][q]; v = xsum<16>(v); v = xsum<32>(v); acc[cd][q] = v; }
        if (lane < 16) {
#pragma unroll
            for (int cd = 0; cd < 5; ++cd) *(f32x4*)(red + (wave * 5 + cd) * 64 + 4 * lane) = acc[cd];
        }
        __syncthreads();
        if (tid < 320) { const int cd = tid >> 6, cc = tid & 63; float s = F.in[10][(size_t)li * 6144 + cb * 64 + cc];
#pragma unroll
            for (int w = 0; w < 8; ++w) s += red[(w * 5 + cd) * 64 + cc];
            MOD[(size_t)(li * 5 + cd) * 6144 + cb * 64 + cc] = s; }
        __syncthreads();
    }
}

__device__ __forceinline__ const float* xrow_ptr(Frame& F, int li, int row) {
    if (li == 0) return (row < MCTX) ? F.in[0] + (size_t)row * DM : F.in[1] + (size_t)(row - MCTX) * DM;
    return (const float*)(F.ws + WS_X) + (size_t)row * DM;
}
__device__ __forceinline__ void phase_norm(Frame& F, int li) {
    FRESH_IDS();
    const int gw = F.bid * NWAVES + wave, NGW = F.G * NWAVES;
    const float* MOD = (const float*)(F.ws + WS_MOD);
    bf16* H = (bf16*)(F.ws + WS_H);
    for (int rowb = gw; rowb < MROWS; rowb += 4 * NGW) {
        int rows[4]; f32x4 v[4][8]; float s[4];
#pragma unroll
        for (int q = 0; q < 4; ++q) { rows[q] = (rowb + q * NGW < MROWS) ? rowb + q * NGW : rowb; const f32x4* xr = (const f32x4*)xrow_ptr(F, li, rows[q]) + lane;
#pragma unroll
            for (int j = 0; j < 8; ++j) v[q][j] = xr[64 * j]; }
        const f32x4* nwp = (const f32x4*)(F.in[8] + (size_t)li * DM) + lane;
        f32x4 w[8];
#pragma unroll
        for (int j = 0; j < 8; ++j) w[j] = nwp[64 * j];
#pragma unroll
        for (int q = 0; q < 4; ++q) { s[q] = 0.f;
#pragma unroll
            for (int j = 0; j < 8; ++j) s[q] += (v[q][j][0] * v[q][j][0] + v[q][j][1] * v[q][j][1]) + (v[q][j][2] * v[q][j][2] + v[q][j][3] * v[q][j][3]); }
#pragma unroll
        for (int q = 0; q < 4; ++q) s[q] = wave_sum(s[q]);
#pragma unroll
        for (int q = 0; q < 4; ++q) { if (q > 0 && rows[q] == rowb) continue;
            const float rstd = rsqrtf(s[q] * (1.f / DM) + EPSF);
            const float* mod = MOD + (size_t)(li * 5 + cond_of_row(rows[q])) * 6144;
            u32x2* o = (u32x2*)(H + (size_t)rows[q] * DM) + lane;
#pragma unroll
            for (int j = 0; j < 8; ++j) { const f32x4 a = ((const f32x4*)mod + lane)[64 * j], b = ((const f32x4*)(mod + DM) + lane)[64 * j];
                const f32x4 h = v[q][j] * rstd * w[j] * (b + 1.f) + a;
                u32x2 p; p.x = pk2(h[0], h[1]); p.y = pk2(h[2], h[3]); o[64 * j] = p; } }
    }
}
__device__ __forceinline__ void phase_final_norm(Frame& F) {
    FRESH_IDS();
    const int gw = F.bid * NWAVES + wave, NGW = F.G * NWAVES;
    for (int rowb = gw; rowb < MROWS; rowb += 4 * NGW) {
        int rows[4]; f32x4 v[4][8]; float s[4];
#pragma unroll
        for (int q = 0; q < 4; ++q) { rows[q] = (rowb + q * NGW < MROWS) ? rowb + q * NGW : rowb; const f32x4* xr = (const f32x4*)(F.ws + WS_X) + (size_t)rows[q] * (DM / 4) + lane;
#pragma unroll
            for (int j = 0; j < 8; ++j) v[q][j] = xr[64 * j]; }
        const f32x4* nwp = (const f32x4*)F.in[24] + lane;
        f32x4 w[8];
#pragma unroll
        for (int j = 0; j < 8; ++j) w[j] = nwp[64 * j];
#pragma unroll
        for (int q = 0; q < 4; ++q) { s[q] = 0.f;
#pragma unroll
            for (int j = 0; j < 8; ++j) s[q] += (v[q][j][0] * v[q][j][0] + v[q][j][1] * v[q][j][1]) + (v[q][j][2] * v[q][j][2] + v[q][j][3] * v[q][j][3]); }
#pragma unroll
        for (int q = 0; q < 4; ++q) s[q] = wave_sum(s[q]);
#pragma unroll
        for (int q = 0; q < 4; ++q) { if (q > 0 && rows[q] == rowb) continue;
            const float rstd = rsqrtf(s[q] * (1.f / DM) + EPSF);
            f32x4* o = (f32x4*)(F.out + OUT_Y) + (size_t)rows[q] * (DM / 4) + lane;
#pragma unroll
            for (int j = 0; j < 8; ++j) o[64 * j] = v[q][j] * rstd * w[j]; }
    }
}

constexpr int QSTR = 136;
constexpr int TSTR = 72;
constexpr int OPS_BYTES = 57344, OPS_W = 0, OPS_Q = 16384, OPS_K = 32768, OPS_A = 49152;
constexpr int DP_QS = 0, DP_KS = 17408, DP_KT = 34816, DP_VT = 53248, DP_LM = 71680, DP_TI = 104448, DP_SC = 122880;
static_assert(DP_SC + 4096 <= LDS_MISC, "delta prep LDS");

__device__ __forceinline__ bf16x8 scale8(bf16x8 v, const float (&s)[8]) {
    u32x4 w;
#pragma unroll
    for (int p = 0; p < 4; ++p) w[p] = pk2(bf2f((unsigned short)v[2 * p]) * s[2 * p], bf2f((unsigned short)v[2 * p + 1]) * s[2 * p + 1]);
    return __builtin_bit_cast(bf16x8, w);
}
__device__ __forceinline__ bf16x8 ld44(const bf16* p0, const bf16* p1) {
    const u32x2 a = *(const u32x2*)p0, b = *(const u32x2*)p1; u32x4 w; w.x = a.x; w.y = a.y; w.z = b.x; w.w = b.y; return __builtin_bit_cast(bf16x8, w);
}

struct ConvIn { unsigned xr[3][12]; float w0[3][5], w1[3][5]; float rb, rg, al, dtb; };
__device__ __forceinline__ void delta_conv_load(Frame& F, ConvIn& C, int e, int tc, int h, int tid) {
    const int lane = tid & 63, wave = tid >> 6, ch = 2 * lane;
    const int m0 = tc * 64; int s0, L; seq_of_row(m0, s0, L); const int t0 = m0 - s0;
    const bf16* P = (const bf16*)(F.ws + WS_P); const float* SM = (const float*)(F.ws + WS_SM);
#pragma unroll
    for (int T = 0; T < 3; ++T) { const int col = T * 1024 + h * 128 + ch;
#pragma unroll
        for (int r = 0; r < 12; ++r) { const int t = t0 + 8 * wave - 2 + r; C.xr[T][r] = 0u; if (t >= 0 && t < L) C.xr[T][r] = *(const unsigned*)(P + (size_t)(s0 + t) * LDP_E + col); } }
#pragma unroll
    for (int T = 0; T < 3; ++T) { const int col = T * 1024 + h * 128 + ch;
#pragma unroll
        for (int j = 0; j < 5; ++j) { const float* cw = F.in[12] + ((size_t)e * 5 + j) * 3072 + col; C.w0[T][j] = cw[0]; C.w1[T][j] = cw[1]; } }
    C.rb = 0.f; C.rg = 0.f; C.al = 0.f; C.dtb = 0.f;
    if (tid < 128) { const float* sm = SM + (size_t)(m0 + (tid & 63)) * 32; C.rb = sm[8 * (tid >> 6) + h]; C.rg = sm[16 + 8 * (tid >> 6) + h];
        C.al = F.in[13][(e * 2 + (tid >> 6)) * 8 + h]; C.dtb = F.in[14][(e * 2 + (tid >> 6)) * 8 + h]; }
}
__device__ __forceinline__ void delta_prep_unit(Frame& F, int e, int tc, int h, ConvIn& C, int tc_next) {
    FRESH_IDS();
    bf16* Qs = (bf16*)(F.smem + DP_QS); bf16* Ks = (bf16*)(F.smem + DP_KS); bf16* Kt = (bf16*)(F.smem + DP_KT); bf16* Vt = (bf16*)(F.smem + DP_VT);
    float* Lm = (float*)(F.smem + DP_LM); bf16* Ti = (bf16*)(F.smem + DP_TI);
    float* sBeta = (float*)(F.smem + DP_SC);
    float* sG = sBeta + 128;
    float* sGc = sG + 128;
    float* sEg = sGc + 128;
    float* sBe = sEg + 128;
    float* sEd = sBe + 128;
    const int m0 = tc * 64; int s0, L; seq_of_row(m0, s0, L); const int t0 = m0 - s0;
    const bf16* P = (const bf16*)(F.ws + WS_P);
    const float* SM = (const float*)(F.ws + WS_SM);
    const int c = lane & 15, g = lane >> 4;
    const float rb_pre = C.rb, rg_pre = C.rg, al_pre = C.al, dtb_pre = C.dtb;
    __syncthreads();
#ifndef REP_CONV
#define REP_CONV 1
#endif
#ifndef REP_INV
#define REP_INV 1
#endif
#ifndef REP_WU
#define REP_WU 1
#endif
#ifndef REP_G
#define REP_G 1
#endif
#pragma unroll 1
    for (int rep_ = 0; rep_ < REP_CONV; ++rep_) {
        const int ch = 2 * lane;
#pragma unroll
        for (int T = 0; T < 3; ++T) {
            float x0[12], x1[12];
#pragma unroll
            for (int r = 0; r < 12; ++r) { x0[r] = bf2f(C.xr[T][r] & 0xffffu); x1[r] = bf2f(C.xr[T][r] >> 16); }
            float y0[8], y1[8], ss[8];
#pragma unroll
            for (int i = 0; i < 8; ++i) { float a0 = 0.f, a1 = 0.f;
#pragma unroll
                for (int j = 0; j < 5; ++j) { a0 += C.w0[T][j] * x0[i + j]; a1 += C.w1[T][j] * x1[i + j]; }
                y0[i] = siluf(a0); y1[i] = siluf(a1); ss[i] = y0[i] * y0[i] + y1[i] * y1[i]; }
            if (T < 2) {
#pragma unroll
                for (int i = 0; i < 8; ++i) ss[i] = wave_sum(ss[i]);
#pragma unroll
                for (int i = 0; i < 8; ++i) { float rn = rsqrtf(ss[i] + EPSF); if (T == 0) rn *= ATT_SCALE; y0[i] *= rn; y1[i] *= rn; }
            }
            if (T < 2) {
#pragma unroll
                for (int i = 0; i < 8; ++i) *(unsigned*)((T == 0 ? Qs : Ks) + (8 * wave + i) * QSTR + ch) = pk2(y0[i], y1[i]);
            }
            if (T >= 1) {
                u32x4 t0, t1;
#pragma unroll
                for (int p = 0; p < 4; ++p) { t0[p] = pk2(y0[2 * p], y0[2 * p + 1]); t1[p] = pk2(y1[2 * p], y1[2 * p + 1]); }
                bf16* Tt = (T == 1) ? Kt : Vt;
                *(u32x4*)(Tt + ch * TSTR + 8 * wave) = t0; *(u32x4*)(Tt + (ch + 1) * TSTR + 8 * wave) = t1;
            }
        }
    }
#ifndef REP_BETA
#define REP_BETA 1
#endif
#ifndef REP_ST
#define REP_ST 1
#endif
#pragma unroll 1
    for (int rep2_ = 0; rep2_ < REP_BETA; ++rep2_) {
    if (tid < 128) { const int d = tid >> 6; const float rb = rb_pre, rg = rg_pre;
        sBeta[tid] = sigmoidf_(rb);
        sG[tid] = -__expf(al_pre) * softplusf_(rg + dtb_pre); }
    __syncthreads();
    if (tid < 128) { const int d = tid >> 6, i = tid & 63; float s = 0.f, tot = 0.f;
        f32x4 gv[16];
#pragma unroll
        for (int j4 = 0; j4 < 16; ++j4) gv[j4] = *(const f32x4*)(sG + d * 64 + 4 * j4);
#pragma unroll
        for (int j = 0; j < 64; ++j) { const float gg = gv[j >> 2][j & 3]; tot += gg; s += ((d == 0) ? (j <= i) : (j >= i)) ? gg : 0.f; }
        sGc[tid] = s; const float eg = __expf(s); sEg[tid] = eg; sBe[tid] = sBeta[tid] * eg; sEd[tid] = __expf(tot - s); }
    __syncthreads();
    }
#pragma unroll 1
    for (int rep_ = 0; rep_ < REP_G; ++rep_)
#pragma unroll
    for (int q = 0; q < 2; ++q) { const int t = wave * 2 + q, ti = t >> 2, tj = t & 3;
        const bf16* A = Ks + (16 * ti + c) * QSTR + 8 * g; const bf16* B = Ks + (16 * tj + c) * QSTR + 8 * g;
        f32x4 acc = {0.f, 0.f, 0.f, 0.f};
#pragma unroll
        for (int kk = 0; kk < 4; ++kk) acc = mfma16(ld8(A + 32 * kk), ld8(B + 32 * kk), acc);
        const int j = 16 * tj + c;
#pragma unroll
        for (int r = 0; r < 4; ++r) { const int i = 16 * ti + 4 * g + r;
            Lm[i * 64 + j] = (j < i) ? sBeta[i] * acc[r] * __expf(sGc[i] - sGc[j]) : 0.f;
            Lm[4096 + (63 - i) * 64 + (63 - j)] = (j > i) ? sBeta[64 + i] * acc[r] * __expf(sGc[64 + i] - sGc[64 + j]) : 0.f; }
    }
#pragma unroll 1
    for (int rep3_ = 0; rep3_ < REP_ST; ++rep3_) {
        const int ib = wave >> 1, kk2 = wave & 1, i = 16 * ib + c;
        f32x4 st[2];
#pragma unroll
        for (int hf = 0; hf < 2; ++hf) { const bf16* A = Ks + (16 * (2 * kk2 + hf) + c) * QSTR + 8 * g; const bf16* B = Qs + (16 * ib + c) * QSTR + 8 * g;
            st[hf] = (f32x4){0.f, 0.f, 0.f, 0.f};
#pragma unroll
            for (int kk = 0; kk < 4; ++kk) st[hf] = mfma16(ld8(A + 32 * kk), ld8(B + 32 * kk), st[hf]); }
#pragma unroll
        for (int d = 0; d < 2; ++d) { f32x4 p[2];
#pragma unroll
            for (int hf = 0; hf < 2; ++hf)
#pragma unroll
                for (int r = 0; r < 4; ++r) { const int j = 32 * kk2 + 16 * hf + 4 * g + r; const bool ok = (d == 0) ? (j <= i) : (j >= i);
                    p[hf][r] = ok ? st[hf][r] * __expf(sGc[d * 64 + i] - sGc[d * 64 + j]) : 0.f; }
            const int unit = (tc * 8 + h) * 2 + d;
            *(bf16x8*)(F.ws + WS_DW + (size_t)unit * OPS_BYTES + OPS_A + (ib * 2 + kk2) * 1024 + lane * 16) = pack_acc(p[0], p[1]); }
    }
    __syncthreads();
#pragma unroll 1
    for (int rep_ = 0; rep_ < REP_INV; ++rep_)
    if (wave < 2) {
        const float* Lp = Lm + wave * 4096;
        float x[64];
        f32x4 cur[16], nxt[16];
#pragma unroll
        for (int j4 = 0; j4 < 16; ++j4) { cur[j4] = (f32x4){0.f, 0.f, 0.f, 0.f}; nxt[j4] = (f32x4){0.f, 0.f, 0.f, 0.f}; }
        cur[0] = *(const f32x4*)(Lp + 64);
        x[0] = (lane == 0) ? 1.f : 0.f;
#pragma unroll
        for (int i = 1; i < 64; ++i) {
            if (i + 1 < 64) {
#pragma unroll
                for (int j4 = 0; j4 < (i + 4) / 4; ++j4) nxt[j4] = *(const f32x4*)(Lp + (i + 1) * 64 + 4 * j4);
            }
            float a[4] = {(lane == i) ? 1.f : 0.f, 0.f, 0.f, 0.f};
#pragma unroll
            for (int j = 0; j < i; ++j) a[j & 3] -= cur[j >> 2][j & 3] * x[j];
            x[i] = (a[0] + a[1]) + (a[2] + a[3]);
#pragma unroll
            for (int j4 = 0; j4 < 16; ++j4) cur[j4] = nxt[j4];
        }
#pragma unroll
        for (int i = 0; i < 64; ++i) { const int ri = wave ? 63 - i : i, rc = wave ? 63 - lane : lane; Ti[wave * 64 * TSTR + ri * TSTR + rc] = (bf16)f2bf(x[i]); }
    } else {
#pragma unroll 1
        for (int f = wave - 2; f < 64; f += 6) {
            const int d = f >> 5, isK = (f >> 4) & 1, fi = f & 15, unit = (tc * 8 + h) * 2 + d;
            bf16x8 o;
            if (!isK) { const int mb = fi >> 2, kk = fi & 3, i = 16 * mb + c; const float sc = sEg[d * 64 + i];
                const bf16x8 v = ld44(Qs + i * QSTR + 32 * kk + 4 * g, Qs + i * QSTR + 32 * kk + 16 + 4 * g);
                const float s8[8] = {sc, sc, sc, sc, sc, sc, sc, sc}; o = scale8(v, s8);
            } else { const int mb = fi >> 1, kk = fi & 1, dk = 16 * mb + c;
                const bf16x8 v = ld44(Kt + dk * TSTR + 32 * kk + 4 * g, Kt + dk * TSTR + 32 * kk + 16 + 4 * g);
                const f32x4 s0v = *(const f32x4*)(sEd + d * 64 + 32 * kk + 4 * g), s1v = *(const f32x4*)(sEd + d * 64 + 32 * kk + 16 + 4 * g);
                const float s8[8] = {s0v[0], s0v[1], s0v[2], s0v[3], s1v[0], s1v[1], s1v[2], s1v[3]}; o = scale8(v, s8); }
            *(bf16x8*)(F.ws + WS_DW + (size_t)unit * OPS_BYTES + (isK ? OPS_K : OPS_Q) + fi * 1024 + lane * 16) = o;
        }
    }
    __syncthreads();
#pragma unroll 1
    for (int rep_ = 0; rep_ < REP_WU; ++rep_) {
        delta_conv_load(F, C, e, tc_next >= 0 ? tc_next : tc, h, tid);
        const int d = wave >> 2, mb = wave & 3, unit = (tc * 8 + h) * 2 + d;
        bf16x8 tr[2];
#pragma unroll
        for (int kk = 0; kk < 2; ++kk) tr[kk] = ld8(Ti + d * 64 * TSTR + (16 * mb + c) * TSTR + 32 * kk + 8 * g);
        float sb[2][8], bt[2][8];
#pragma unroll
        for (int kk = 0; kk < 2; ++kk)
#pragma unroll
            for (int j = 0; j < 8; ++j) { sb[kk][j] = sBe[d * 64 + 32 * kk + 8 * g + j]; bt[kk][j] = sBeta[d * 64 + 32 * kk + 8 * g + j]; }
#pragma unroll
        for (int kq = 0; kq < 4; ++kq) { f32x4 wt[2];
#pragma unroll
            for (int hf = 0; hf < 2; ++hf) { const int dk = 16 * (2 * kq + hf) + c; wt[hf] = (f32x4){0.f, 0.f, 0.f, 0.f};
#pragma unroll
                for (int kk = 0; kk < 2; ++kk) wt[hf] = mfma16(scale8(ld8(Kt + dk * TSTR + 32 * kk + 8 * g), sb[kk]), tr[kk], wt[hf]); }
            *(bf16x8*)(F.ws + WS_DW + (size_t)unit * OPS_BYTES + OPS_W + (mb * 4 + kq) * 1024 + lane * 16) = pack_acc(wt[0], wt[1]); }
        float* DU = (float*)(F.ws + WS_DU) + (size_t)unit * 8192;
#pragma unroll 4
        for (int nb = 0; nb < 8; ++nb) { const int dv = 16 * nb + c; f32x4 u = {0.f, 0.f, 0.f, 0.f};
#pragma unroll
            for (int kk = 0; kk < 2; ++kk) u = mfma16(tr[kk], scale8(ld8(Vt + dv * TSTR + 32 * kk + 8 * g), bt[kk]), u);
            *(f32x4*)(DU + ((nb * 4 + mb) * 64 + lane) * 4) = u; }
        if (tid < 2) ((float*)(F.ws + WS_DG))[(tc * 8 + h) * 2 + tid] = __expf(tid == 0 ? sGc[63] : sGc[64]);
    }
}

__device__ __forceinline__ void ops_dma(LAS unsigned char* dst, const unsigned char* src, int nchunks, int wave, int lane) {
    for (int q = wave; q < nchunks; q += NWAVES)
        __builtin_amdgcn_global_load_lds((const unsigned*)(src + q * 1024 + lane * 16), (LAS unsigned*)(dst + q * 1024), 16, 0, 0);
}
__device__ __forceinline__ void delta_step(const unsigned char* buf, const f32x4 (&uc)[4], float eg, f32x4 (&sacc)[8], f32x4 (&o)[4], int lane) {
    const unsigned char* lb = buf + lane * 16;
    bf16x8 bS[4];
#pragma unroll
    for (int kk = 0; kk < 4; ++kk) bS[kk] = pack_acc(sacc[2 * kk], sacc[2 * kk + 1]);
    f32x4 vn[4];
#pragma unroll
    for (int mp = 0; mp < 2; ++mp) {
        bf16x8 wf[2][4], qf[2][4];
#pragma unroll
        for (int m2 = 0; m2 < 2; ++m2)
#pragma unroll
            for (int kk = 0; kk < 4; ++kk) { wf[m2][kk] = *(const bf16x8*)(lb + OPS_W + ((2 * mp + m2) * 4 + kk) * 1024); qf[m2][kk] = *(const bf16x8*)(lb + OPS_Q + ((2 * mp + m2) * 4 + kk) * 1024); }
        __builtin_amdgcn_sched_barrier(0);
#pragma unroll
        for (int m2 = 0; m2 < 2; ++m2) { f32x4 a = {0.f, 0.f, 0.f, 0.f}, q = {0.f, 0.f, 0.f, 0.f};
#pragma unroll
            for (int kk = 0; kk < 4; ++kk) { a = mfma16(wf[m2][kk], bS[kk], a); q = mfma16(qf[m2][kk], bS[kk], q); }
            vn[2 * mp + m2] = uc[2 * mp + m2] - a; o[2 * mp + m2] = q; }
    }
    bf16x8 af[4][2], kf[8][2];
#pragma unroll
    for (int mb = 0; mb < 4; ++mb)
#pragma unroll
        for (int kk = 0; kk < 2; ++kk) af[mb][kk] = *(const bf16x8*)(lb + OPS_A + (mb * 2 + kk) * 1024);
#pragma unroll
    for (int mb = 0; mb < 8; ++mb)
#pragma unroll
        for (int kk = 0; kk < 2; ++kk) kf[mb][kk] = *(const bf16x8*)(lb + OPS_K + (mb * 2 + kk) * 1024);
    __builtin_amdgcn_sched_barrier(0);
    bf16x8 bV[2];
#pragma unroll
    for (int kk = 0; kk < 2; ++kk) bV[kk] = pack_acc(vn[2 * kk], vn[2 * kk + 1]);
#pragma unroll
    for (int mb = 0; mb < 8; ++mb) { sacc[mb] = sacc[mb] * eg;
#pragma unroll
        for (int kk = 0; kk < 2; ++kk) sacc[mb] = mfma16(kf[mb][kk], bV[kk], sacc[mb]); }
#pragma unroll
    for (int mb = 0; mb < 4; ++mb) {
#pragma unroll
        for (int kk = 0; kk < 2; ++kk) o[mb] = mfma16(af[mb][kk], bV[kk], o[mb]); }
}
__device__ __forceinline__ void scan_store(float* outp, const f32x4 (&o)[4]) {
#pragma unroll
    for (int mb = 0; mb < 4; ++mb)
#pragma unroll
        for (int r = 0; r < 4; ++r) outp[(size_t)(16 * mb + r) * 1024] = o[mb][r];
}
#define TOUCH4(u) asm volatile("" : "+v"(u[0]), "+v"(u[1]), "+v"(u[2]), "+v"(u[3]))
__device__ __forceinline__ void delta_scan_unit(Frame& F, int e, int ch) {
    FRESH_IDS();
    const int c = lane & 15, g = lane >> 4, dv0 = 16 * wave;
    const bool lat = ch >= 256; const int cc = lat ? ch - 256 : ch; const int seq = cc >> 4, h = (cc >> 1) & 7, d = cc & 1;
    const int nchunk = lat ? 16 : 4, tcbase = lat ? 64 + seq * 16 : seq * 4;
    f32x4 sacc[8];
    if (lat) { const float* S0 = F.in[2] + ((size_t)(((seq * 2 + e) * 2 + d) * 8 + h)) * 16384;
#pragma unroll
        for (int mb = 0; mb < 8; ++mb)
#pragma unroll
            for (int r = 0; r < 4; ++r) sacc[mb][r] = S0[(16 * mb + 4 * g + r) * 128 + dv0 + c];
    } else {
#pragma unroll
        for (int mb = 0; mb < 8; ++mb) sacc[mb] = (f32x4){0.f, 0.f, 0.f, 0.f};
    }
    const unsigned char* OPS = F.ws + WS_DW; const float* DU = (const float*)(F.ws + WS_DU); const float* DG = (const float*)(F.ws + WS_DG);
    float* OUT = (float*)(F.ws + (d ? WS_OB : WS_OF)) + (size_t)(4 * g) * 1024 + h * 128 + dv0 + c;
    const int uoff = (wave * 4 * 64 + lane) * 4;
    __syncthreads();
#define DUNIT(st) (((tcbase + (d ? nchunk - 1 - (st) : (st))) * 8 + h) * 2 + d)
    f32x4 uA[4], uB[4], oprev[4]; float egA, egB;
    { const int unit = DUNIT(0);
      ops_dma(F.lds, OPS + (size_t)unit * OPS_BYTES, 56, wave, lane);
#pragma unroll
      for (int mb = 0; mb < 4; ++mb) uA[mb] = *(const f32x4*)(DU + (size_t)unit * 8192 + uoff + mb * 256);
      egA = DG[unit]; }
#pragma unroll 1
    for (int step = 0; step < nchunk; step += 2) {
        asm volatile("s_waitcnt vmcnt(0)" ::: "memory");
        __syncthreads();
        TOUCH4(uA); asm volatile("" : "+v"(egA));
        { const int unit = DUNIT(step + 1);
#pragma unroll
          for (int mb = 0; mb < 4; ++mb) uB[mb] = *(const f32x4*)(DU + (size_t)unit * 8192 + uoff + mb * 256);
          egB = DG[unit];
          ops_dma(F.lds + OPS_BYTES, OPS + (size_t)unit * OPS_BYTES, 56, wave, lane); }
        if (step > 0) scan_store(OUT + (size_t)((tcbase + (d ? nchunk - step : step - 1)) * 64) * 1024, oprev);
        delta_step(F.smem, uA, egA, sacc, oprev, lane);
        asm volatile("" ::: "memory");
        asm volatile("s_waitcnt vmcnt(0)" ::: "memory");
        __syncthreads();
        TOUCH4(uB); asm volatile("" : "+v"(egB));
        { const bool more = step + 2 < nchunk; const int unit = DUNIT(more ? step + 2 : step + 1);
#pragma unroll
          for (int mb = 0; mb < 4; ++mb) uA[mb] = *(const f32x4*)(DU + (size_t)unit * 8192 + uoff + mb * 256);
          egA = DG[unit];
          if (more) ops_dma(F.lds, OPS + (size_t)unit * OPS_BYTES, 56, wave, lane); }
        scan_store(OUT + (size_t)((tcbase + (d ? nchunk - 1 - step : step)) * 64) * 1024, oprev);
        delta_step(F.smem + OPS_BYTES, uB, egB, sacc, oprev, lane);
        asm volatile("" ::: "memory");
    }
    scan_store(OUT + (size_t)((tcbase + (d ? 0 : nchunk - 1)) * 64) * 1024, oprev);
#undef DUNIT
    if (!lat) { float* SO = F.out + OUT_SD + ((size_t)(((seq * 2 + e) * 2 + d) * 8 + h)) * 16384;
#pragma unroll
        for (int mb = 0; mb < 8; ++mb)
#pragma unroll
            for (int r = 0; r < 4; ++r) SO[(16 * mb + 4 * g + r) * 128 + dv0 + c] = sacc[mb][r]; }
}

struct CombRow { float v[16]; bf16x8 z0, z1, kv; };
__device__ __forceinline__ void comb_even_load(Frame& F, CombRow& R, int row, int lane) {
    const float* OF = (const float*)(F.ws + WS_OF) + (size_t)row * 1024 + 16 * lane; const float* OB = (const float*)(F.ws + WS_OB) + (size_t)row * 1024 + 16 * lane;
    const bf16* P = (const bf16*)(F.ws + WS_P) + (size_t)row * LDP_E;
#pragma unroll
    for (int q = 0; q < 4; ++q) { const f32x4 a = *(const f32x4*)(OF + 4 * q), b = *(const f32x4*)(OB + 4 * q);
#pragma unroll
        for (int r = 0; r < 4; ++r) R.v[4 * q + r] = a[r] + b[r]; }
    R.z0 = ld8(P + E_ZA + 16 * lane); R.z1 = ld8(P + E_ZA + 16 * lane + 8);
    R.kv = ld8(P + E_KB + 8 * lane);
}
__device__ __forceinline__ void comb_even_finish(Frame& F, const CombRow& R, int row, int e, int lane, const float (&on)[16]) {
    const int ch0 = 16 * lane;
    float ss = 0.f;
#pragma unroll
    for (int i = 0; i < 16; ++i) ss += R.v[i] * R.v[i];
    ss = xsum<1>(ss); ss = xsum<2>(ss); ss = xsum<4>(ss);
    const float rstd = rsqrtf(ss * (1.f / 128.f) + EPSF);
    unsigned w[8];
#pragma unroll
    for (int q = 0; q < 8; ++q) { float o2[2];
#pragma unroll
        for (int hh = 0; hh < 2; ++hh) { const int i = 2 * q + hh; const float z = bf2f((unsigned short)(i < 8 ? R.z0[i] : R.z1[i - 8]));
            o2[hh] = R.v[i] * rstd * on[i] * siluf(z); }
        w[q] = pk2(o2[0], o2[1]); }
    bf16* OM = (bf16*)(F.ws + WS_OMIX) + (size_t)row * DM + ch0;
    u32x4 w0, w1; w0.x = w[0]; w0.y = w[1]; w0.z = w[2]; w0.w = w[3]; w1.x = w[4]; w1.y = w[5]; w1.z = w[6]; w1.w = w[7];
    *(u32x4*)OM = w0; *(u32x4*)(OM + 8) = w1;
    if (row < MCTX) {
        const int b = row >> 8, t = row & 255, which = lane >> 5, off = 8 * (lane & 31);
        float* dst = F.out + OUT_KVW + ((size_t)((b * 2 + e) * 2 + which) * 256 + t) * 256 + off;
        f32x4 a, bb;
#pragma unroll
        for (int r = 0; r < 4; ++r) { a[r] = bf2f((unsigned short)R.kv[r]); bb[r] = bf2f((unsigned short)R.kv[4 + r]); }
        *(f32x4*)dst = a; *(f32x4*)(dst + 4) = bb;
    }
}
__device__ __forceinline__ void phase_combine_even(Frame& F, int e) {
    FRESH_IDS();
    const int gw = F.bid * NWAVES + wave, NGW = F.G * NWAVES;
    float on[16];
#pragma unroll
    for (int i = 0; i < 16; ++i) on[i] = F.in[15][e * 128 + ((16 * lane + i) & 127)];
    for (int rowb = gw; rowb < MROWS; rowb += 4 * NGW) {
        CombRow R[4]; int rows[4];
#pragma unroll
        for (int q = 0; q < 4; ++q) { rows[q] = (rowb + q * NGW < MROWS) ? rowb + q * NGW : rowb; comb_even_load(F, R[q], rows[q], lane); }
#pragma unroll
        for (int q = 0; q < 4; ++q) { if (q > 0 && rows[q] == rowb) continue; comb_even_finish(F, R[q], rows[q], e, lane, on); }
    }
}

constexpr int GOPS_BYTES = 41984, GOPS_Q = 0, GOPS_K = 16384, GOPS_A = 32768, GOPS_D = 40960;
constexpr int BSTR = 132;
constexpr int GP_QS = 0, GP_KS = 17408, GP_KT = 34816, GP_BB = 53248, GP_LR = 87040, GP_VT = 95232, GP_QG = 95232, GP_KN = 112640;
static_assert(GP_VT + 36864 <= LDS_MISC && GP_KN + 17408 <= LDS_MISC, "gla prep LDS");

__device__ __forceinline__ void gla_prep_unit(Frame& F, int o, int tc, int h) {
    FRESH_IDS();
    bf16* Qs = (bf16*)(F.smem + GP_QS); bf16* Ks = (bf16*)(F.smem + GP_KS); bf16* Kt = (bf16*)(F.smem + GP_KT); bf16* Vt = (bf16*)(F.smem + GP_VT);
    bf16* Qg = (bf16*)(F.smem + GP_QG); bf16* Kn = (bf16*)(F.smem + GP_KN);
    float* BB = (float*)(F.smem + GP_BB); float* LR = (float*)(F.smem + GP_LR);
    const int m0 = tc * 64, c = lane & 15, g = lane >> 4;
    const bf16* P = (const bf16*)(F.ws + WS_P); const float* SM = (const float*)(F.ws + WS_SM);
    float wv2[2][16], bias2[2];
#pragma unroll
    for (int d = 0; d < 2; ++d) { bias2[d] = F.in[20][(size_t)(o * 2 + d) * 512 + h * 128 + (tid & 127)];
#pragma unroll
        for (int r = 0; r < 16; ++r) wv2[d][r] = F.in[19][((size_t)(o * 2 + d) * 16 + r) * 512 + h * 128 + (tid & 127)]; }
    __syncthreads();
    for (int idx = tid; idx < 64 * 16; idx += NTHREADS) { const int i = idx & 63, c8 = idx >> 6;
        const bf16x8 q = ld8(P + (size_t)(m0 + i) * LDP_O + O_QC + h * 128 + 8 * c8), k = ld8(P + (size_t)(m0 + i) * LDP_O + O_KC + h * 128 + 8 * c8);
        u32x4 ww;
#pragma unroll
        for (int jp = 0; jp < 4; ++jp) ww[jp] = pk2(bf2f((unsigned short)q[2 * jp]) * ATT_SCALE, bf2f((unsigned short)q[2 * jp + 1]) * ATT_SCALE);
        *(u32x4*)(Qs + i * QSTR + 8 * c8) = ww; *(bf16x8*)(Ks + i * QSTR + 8 * c8) = k;
#pragma unroll
        for (int r = 0; r < 8; ++r) Kt[(8 * c8 + r) * TSTR + i] = (bf16)k[r]; }
    for (int idx = tid; idx < 64 * 32; idx += NTHREADS) { const int i = idx & 63, dg = idx >> 6;
        const bf16x8 v = ld8(P + (size_t)(m0 + i) * LDP_O + O_VC + h * 256 + 8 * dg);
#pragma unroll
        for (int r = 0; r < 8; ++r) Vt[(8 * dg + r) * TSTR + i] = (bf16)v[r]; }
    for (int idx = tid; idx < 64 * 32; idx += NTHREADS) LR[idx] = SM[(size_t)(m0 + (idx >> 5)) * 32 + (idx & 31)];
    __syncthreads();
    { unsigned char* GV = F.ws + WS_GV + (size_t)(tc * 4 + h) * 32768;
#pragma unroll
      for (int q = 0; q < 4; ++q) { const int f = wave * 4 + q, nb = f >> 1, kk = f & 1;
          *(bf16x8*)(GV + f * 1024 + lane * 16) = ld44(Vt + (16 * nb + c) * TSTR + 32 * kk + 4 * g, Vt + (16 * nb + c) * TSTR + 32 * kk + 16 + 4 * g); } }
    __syncthreads();
#pragma unroll 1
    for (int d = 0; d < 2; ++d) {
        unsigned char* GO = F.ws + WS_GO + (size_t)((tc * 4 + h) * 2 + d) * GOPS_BYTES;
        { const int dk = tid & 127, i0 = (tid >> 7) * 16;
          float wv[16];
#pragma unroll
          for (int r = 0; r < 16; ++r) wv[r] = d ? wv2[1][r] : wv2[0][r];
          const float bias = d ? bias2[1] : bias2[0];
          float run = 0.f;
#pragma unroll 4
          for (int ii = 0; ii < 16; ++ii) { const int i = i0 + (d == 0 ? ii : 15 - ii); float s = bias;
#pragma unroll
              for (int r = 0; r < 16; ++r) s += LR[i * 32 + 16 * d + r] * wv[r];
              run += logsigmoidf_(s) * (1.f / 16.f); BB[i * BSTR + dk] = run; }
        }
        __syncthreads();
        { const int dk = tid & 127, qd = tid >> 7, i0 = qd * 16; float off = 0.f;
          if (d == 0) { for (int qq = 0; qq < qd; ++qq) off += BB[(qq * 16 + 15) * BSTR + dk]; }
          else { for (int qq = qd + 1; qq < 4; ++qq) off += BB[(qq * 16) * BSTR + dk]; }
          __syncthreads();
          for (int ii = 0; ii < 16; ++ii) BB[(i0 + ii) * BSTR + dk] += off; }
        __syncthreads();
#pragma unroll 4
        for (int it = 0; it < 16; ++it) { const int idx = tid + 512 * it, i = idx >> 7, dk = idx & 127;
            const float b = BB[i * BSTR + dk];
            Qg[i * QSTR + dk] = (bf16)f2bf(bf2f(Qs[i * QSTR + dk]) * __expf(b)); Kn[i * QSTR + dk] = (bf16)f2bf(bf2f(Ks[i * QSTR + dk]) * __expf(-b)); }
        const int blrow = (d == 0) ? 63 : 0;
#pragma unroll
        for (int q = 0; q < 2; ++q) { const int fi = wave * 2 + q;
            { const int mb = fi >> 2, kk = fi & 3, i = 16 * mb + c;
              const bf16x8 v = ld44(Qs + i * QSTR + 32 * kk + 4 * g, Qs + i * QSTR + 32 * kk + 16 + 4 * g);
              const f32x4 b0 = *(const f32x4*)(BB + i * BSTR + 32 * kk + 4 * g), b1 = *(const f32x4*)(BB + i * BSTR + 32 * kk + 16 + 4 * g);
              const float s8[8] = {__expf(b0[0]), __expf(b0[1]), __expf(b0[2]), __expf(b0[3]), __expf(b1[0]), __expf(b1[1]), __expf(b1[2]), __expf(b1[3])};
              *(bf16x8*)(GO + GOPS_Q + fi * 1024 + lane * 16) = scale8(v, s8); }
            { const int mb = fi >> 1, kk = fi & 1, dk = 16 * mb + c;
              const bf16x8 v = ld44(Kt + dk * TSTR + 32 * kk + 4 * g, Kt + dk * TSTR + 32 * kk + 16 + 4 * g);
              const float bl = BB[blrow * BSTR + dk]; float s8[8];
#pragma unroll
              for (int jj = 0; jj < 8; ++jj) s8[jj] = __expf(bl - BB[(32 * kk + 16 * (jj >> 2) + 4 * g + (jj & 3)) * BSTR + dk]);
              *(bf16x8*)(GO + GOPS_K + fi * 1024 + lane * 16) = scale8(v, s8); } }
        if (tid < 128) *(float*)(GO + GOPS_D + tid * 4) = __expf(BB[blrow * BSTR + tid]);
        __syncthreads();
        {
            const int ib = wave >> 1, kk2 = wave & 1, i = 16 * ib + c;
            f32x4 st[2];
#pragma unroll
            for (int hf = 0; hf < 2; ++hf) { const bf16* A = Kn + (16 * (2 * kk2 + hf) + c) * QSTR + 8 * g; const bf16* B = Qg + (16 * ib + c) * QSTR + 8 * g;
                st[hf] = (f32x4){0.f, 0.f, 0.f, 0.f};
#pragma unroll
                for (int kk = 0; kk < 4; ++kk) st[hf] = mfma16(ld8(A + 32 * kk), ld8(B + 32 * kk), st[hf]);
#pragma unroll
                for (int r = 0; r < 4; ++r) { const int j = 32 * kk2 + 16 * hf + 4 * g + r; const bool ok = (d == 0) ? (j <= i) : (j >= i); if (!ok) st[hf][r] = 0.f; } }
            *(bf16x8*)(GO + GOPS_A + (ib * 2 + kk2) * 1024 + lane * 16) = pack_acc(st[0], st[1]);
        }
        __syncthreads();
    }
}

__device__ __forceinline__ void gla_step(const unsigned char* buf, const bf16x8 (&bV)[2], f32x4 (&sacc)[8], f32x4 (&o)[4], int lane, int g) {
    const unsigned char* lb = buf + lane * 16;
    bf16x8 bS[4];
#pragma unroll
    for (int kk = 0; kk < 4; ++kk) bS[kk] = pack_acc(sacc[2 * kk], sacc[2 * kk + 1]);
#pragma unroll
    for (int mp = 0; mp < 2; ++mp) {
        bf16x8 qf[2][4], af[2][2];
#pragma unroll
        for (int m2 = 0; m2 < 2; ++m2) {
#pragma unroll
            for (int kk = 0; kk < 4; ++kk) qf[m2][kk] = *(const bf16x8*)(lb + GOPS_Q + ((2 * mp + m2) * 4 + kk) * 1024);
#pragma unroll
            for (int kk = 0; kk < 2; ++kk) af[m2][kk] = *(const bf16x8*)(lb + GOPS_A + ((2 * mp + m2) * 2 + kk) * 1024); }
        __builtin_amdgcn_sched_barrier(0);
#pragma unroll
        for (int m2 = 0; m2 < 2; ++m2) { f32x4 ov = {0.f, 0.f, 0.f, 0.f};
#pragma unroll
            for (int kk = 0; kk < 4; ++kk) ov = mfma16(qf[m2][kk], bS[kk], ov);
#pragma unroll
            for (int kk = 0; kk < 2; ++kk) ov = mfma16(af[m2][kk], bV[kk], ov);
            o[2 * mp + m2] = ov; }
    }
    bf16x8 kf[8][2]; f32x4 dec[8];
#pragma unroll
    for (int mb = 0; mb < 8; ++mb) { dec[mb] = *(const f32x4*)(buf + GOPS_D + (16 * mb + 4 * g) * 4);
#pragma unroll
        for (int kk = 0; kk < 2; ++kk) kf[mb][kk] = *(const bf16x8*)(lb + GOPS_K + (mb * 2 + kk) * 1024); }
    __builtin_amdgcn_sched_barrier(0);
#pragma unroll
    for (int mb = 0; mb < 8; ++mb) { sacc[mb] = sacc[mb] * dec[mb];
#pragma unroll
        for (int kk = 0; kk < 2; ++kk) sacc[mb] = mfma16(kf[mb][kk], bV[kk], sacc[mb]); }
}
__device__ __forceinline__ void gla_scan_unit(Frame& F, int o, int ch, int half) {
    FRESH_IDS();
    const int c = lane & 15, g = lane >> 4, nb = 8 * half + wave, dv0 = 16 * nb;
    const bool lat = ch >= 128; const int cc = lat ? ch - 128 : ch; const int seq = cc >> 3, h = (cc >> 1) & 3, d = cc & 1;
    const int nchunk = lat ? 16 : 4, tcbase = lat ? 64 + seq * 16 : seq * 4;
    f32x4 sacc[8];
    if (lat) { const float* S0 = F.in[4] + ((size_t)(((seq * 2 + o) * 2 + d) * 4 + h)) * 32768;
#pragma unroll
        for (int mb = 0; mb < 8; ++mb)
#pragma unroll
            for (int r = 0; r < 4; ++r) sacc[mb][r] = S0[(16 * mb + 4 * g + r) * 256 + dv0 + c];
    } else {
#pragma unroll
        for (int mb = 0; mb < 8; ++mb) sacc[mb] = (f32x4){0.f, 0.f, 0.f, 0.f};
    }
    const unsigned char* GO = F.ws + WS_GO; const unsigned char* GV = F.ws + WS_GV + (size_t)nb * 2048 + lane * 16;
    float* OUT = (float*)(F.ws + (d ? WS_OB : WS_OF)) + (size_t)(4 * g) * 1024 + h * 256 + dv0 + c;
    __syncthreads();
#define GTC(st) (tcbase + (d ? nchunk - 1 - (st) : (st)))
    bf16x8 vA[2], vB[2]; f32x4 oprev[4];
    { const int tc = GTC(0);
      ops_dma(F.lds, GO + (size_t)((tc * 4 + h) * 2 + d) * GOPS_BYTES, 41, wave, lane);
      vA[0] = *(const bf16x8*)(GV + (size_t)(tc * 4 + h) * 32768); vA[1] = *(const bf16x8*)(GV + (size_t)(tc * 4 + h) * 32768 + 1024); }
#pragma unroll 1
    for (int step = 0; step < nchunk; step += 2) {
        asm volatile("s_waitcnt vmcnt(0)" ::: "memory");
        __syncthreads();
        asm volatile("" : "+v"(vA[0]), "+v"(vA[1]));
        { const int tc = GTC(step + 1);
          vB[0] = *(const bf16x8*)(GV + (size_t)(tc * 4 + h) * 32768); vB[1] = *(const bf16x8*)(GV + (size_t)(tc * 4 + h) * 32768 + 1024);
          ops_dma(F.lds + GOPS_BYTES, GO + (size_t)((tc * 4 + h) * 2 + d) * GOPS_BYTES, 41, wave, lane); }
        if (step > 0) scan_store(OUT + (size_t)(GTC(step - 1) * 64) * 1024, oprev);
        gla_step(F.smem, vA, sacc, oprev, lane, g);
        asm volatile("" ::: "memory");
        asm volatile("s_waitcnt vmcnt(0)" ::: "memory");
        __syncthreads();
        asm volatile("" : "+v"(vB[0]), "+v"(vB[1]));
        { const bool more = step + 2 < nchunk; const int tc = GTC(more ? step + 2 : step + 1);
          vA[0] = *(const bf16x8*)(GV + (size_t)(tc * 4 + h) * 32768); vA[1] = *(const bf16x8*)(GV + (size_t)(tc * 4 + h) * 32768 + 1024);
          if (more) ops_dma(F.lds, GO + (size_t)((tc * 4 + h) * 2 + d) * GOPS_BYTES, 41, wave, lane); }
        scan_store(OUT + (size_t)(GTC(step) * 64) * 1024, oprev);
        gla_step(F.smem + GOPS_BYTES, vB, sacc, oprev, lane, g);
        asm volatile("" ::: "memory");
    }
    scan_store(OUT + (size_t)(GTC(nchunk - 1) * 64) * 1024, oprev);
#undef GTC
    if (!lat) { float* SO = F.out + OUT_SG + ((size_t)(((seq * 2 + o) * 2 + d) * 4 + h)) * 32768;
#pragma unroll
        for (int mb = 0; mb < 8; ++mb)
#pragma unroll
            for (int r = 0; r < 4; ++r) SO[(16 * mb + 4 * g + r) * 256 + dv0 + c] = sacc[mb][r]; }
}

struct CombRowO { float v[16]; bf16x8 z0, z1, kv[4], od0, od1, zd0, zd1; };
__device__ __forceinline__ void comb_odd_load(Frame& F, CombRowO& R, int row, int lane) {
    const float* OF = (const float*)(F.ws + WS_OF) + (size_t)row * 1024 + 16 * lane; const float* OB = (const float*)(F.ws + WS_OB) + (size_t)row * 1024 + 16 * lane;
    const bf16* P = (const bf16*)(F.ws + WS_P) + (size_t)row * LDP_O;
#pragma unroll
    for (int q = 0; q < 4; ++q) { const f32x4 a = *(const f32x4*)(OF + 4 * q), b = *(const f32x4*)(OB + 4 * q);
#pragma unroll
        for (int r = 0; r < 4; ++r) R.v[4 * q + r] = a[r] + b[r]; }
    R.z0 = ld8(P + O_ZC + 16 * lane); R.z1 = ld8(P + O_ZC + 16 * lane + 8);
    R.zd0 = ld8(P + O_ZD + 16 * lane); R.zd1 = ld8(P + O_ZD + 16 * lane + 8);
    { const bf16* OD = (const bf16*)(F.ws + WS_OMIX) + (size_t)row * DM + 1024 + 16 * lane; R.od0 = ld8(OD); R.od1 = ld8(OD + 8); }
    if (row < MCTX) {
#pragma unroll
        for (int q = 0; q < 4; ++q) R.kv[q] = ld8(P + O_KD + 8 * lane + 512 * q);
    }
}
__device__ __forceinline__ void comb_odd_finish(Frame& F, const CombRowO& R, int row, int o, int lane, const float (&on)[16]) {
    const int ch0 = 16 * lane;
    float ss = 0.f;
#pragma unroll
    for (int i = 0; i < 16; ++i) ss += R.v[i] * R.v[i];
    ss = xsum<1>(ss); ss = xsum<2>(ss); ss = xsum<4>(ss); ss = xsum<8>(ss);
    const float rstd = rsqrtf(ss * (1.f / 256.f) + EPSF);
    unsigned w[8];
#pragma unroll
    for (int q = 0; q < 8; ++q) { float o2[2];
#pragma unroll
        for (int hh = 0; hh < 2; ++hh) { const int i = 2 * q + hh; const float z = bf2f((unsigned short)(i < 8 ? R.z0[i] : R.z1[i - 8]));
            o2[hh] = R.v[i] * rstd * on[i] * siluf(z); }
        w[q] = pk2(o2[0], o2[1]); }
    bf16* OM = (bf16*)(F.ws + WS_OMIX) + (size_t)row * DM + ch0;
    u32x4 w0, w1; w0.x = w[0]; w0.y = w[1]; w0.z = w[2]; w0.w = w[3]; w1.x = w[4]; w1.y = w[5]; w1.z = w[6]; w1.w = w[7];
    *(u32x4*)OM = w0; *(u32x4*)(OM + 8) = w1;
    { u32x4 g0, g1;
#pragma unroll
      for (int q = 0; q < 4; ++q) { g0[q] = pk2(bf2f((unsigned short)R.od0[2 * q]) * siluf(bf2f((unsigned short)R.zd0[2 * q])), bf2f((unsigned short)R.od0[2 * q + 1]) * siluf(bf2f((unsigned short)R.zd0[2 * q + 1])));
                                    g1[q] = pk2(bf2f((unsigned short)R.od1[2 * q]) * siluf(bf2f((unsigned short)R.zd1[2 * q])), bf2f((unsigned short)R.od1[2 * q + 1]) * siluf(bf2f((unsigned short)R.zd1[2 * q + 1]))); }
      *(u32x4*)(OM + 1024) = g0; *(u32x4*)(OM + 1024 + 8) = g1; }
    if (row < MCTX) {
        const int b = row >> 8, t = row & 255;
#pragma unroll
        for (int q = 0; q < 4; ++q) { const int e0 = 8 * lane + 512 * q, which = e0 >> 10, off = e0 & 1023;
            float* dst = F.out + OUT_KVN + ((size_t)((b * 2 + o) * 2 + which) * 256 + t) * 1024 + off;
            f32x4 a, bb;
#pragma unroll
            for (int r = 0; r < 4; ++r) { a[r] = bf2f((unsigned short)R.kv[q][r]); bb[r] = bf2f((unsigned short)R.kv[q][4 + r]); }
            *(f32x4*)dst = a; *(f32x4*)(dst + 4) = bb; }
    }
}
__device__ __forceinline__ void phase_combine_odd(Frame& F, int o) {
    FRESH_IDS();
    const int gw = F.bid * NWAVES + wave, NGW = F.G * NWAVES;
    float on[16];
#pragma unroll
    for (int i = 0; i < 16; ++i) on[i] = F.in[21][o * 256 + ((16 * lane + i) & 255)];
    for (int row0 = gw; row0 < MROWS; row0 += 2 * NGW) {
        const int row1 = row0 + NGW; const bool two = row1 < MROWS;
        CombRowO A, B;
        comb_odd_load(F, A, row0, lane); comb_odd_load(F, B, two ? row1 : row0, lane);
        comb_odd_finish(F, A, row0, o, lane, on); if (two) comb_odd_finish(F, B, row1, o, lane, on);
    }
}

__device__ __forceinline__ void rope_token(Frame& F, int lt) {
    FRESH_IDS();
    const int axis = lane >> 5, i = lane & 31, t = lt & 1023;
    const float* tab = (const float*)(F.ws + WS_ROPE) + ((axis ? (t & 63) : (t >> 6)) * 32 + i) * 2;
    const float cs = tab[0], sn = tab[1];
    const bf16* P = (const bf16*)(F.ws + WS_P) + (size_t)(MCTX + lt) * LDP_E;
    bf16* QR = (bf16*)(F.ws + WS_QR) + (size_t)lt * 1024;
#pragma unroll
    for (int hq = 0; hq < 8; ++hq) { const int o = hq * 128 + axis * 64 + i; const float x1 = bf2f(P[E_QB + o]), x2 = bf2f(P[E_QB + o + 32]);
        QR[o] = (bf16)f2bf(x1 * cs - x2 * sn); QR[o + 32] = (bf16)f2bf(x2 * cs + x1 * sn); }
}
__device__ __forceinline__ void rope_table(Frame& F) {
    FRESH_IDS();
    for (int idx = F.bid * NTHREADS + tid; idx < 64 * 32; idx += F.G * NTHREADS) { const int pos = idx >> 5, i = idx & 31;
        const float freq = __expf(-(float)i * (9.210340371976184f / 32.f)); float sn, cs; sincosf((float)pos * freq, &sn, &cs);
        float* tab = (float*)(F.ws + WS_ROPE) + idx * 2; tab[0] = cs; tab[1] = sn; }
}

constexpr int AT_TILE = 32768, AT_V = 16384;
__device__ __forceinline__ void vfrag_store(unsigned char* dst, const unsigned (&vw)[8], int r, int lane) {
    u32x4 ae, ao;
    ae.x = (vw[0] & 0xffffu) | (vw[1] << 16); ae.y = (vw[2] & 0xffffu) | (vw[3] << 16); ae.z = (vw[4] & 0xffffu) | (vw[5] << 16); ae.w = (vw[6] & 0xffffu) | (vw[7] << 16);
    ao.x = (vw[0] >> 16) | (vw[1] & 0xffff0000u); ao.y = (vw[2] >> 16) | (vw[3] & 0xffff0000u); ao.z = (vw[4] >> 16) | (vw[5] & 0xffff0000u); ao.w = (vw[6] >> 16) | (vw[7] & 0xffff0000u);
    *(u32x4*)(dst + AT_V + (2 * r) * 1024 + lane * 16) = ae; *(u32x4*)(dst + AT_V + (2 * r + 1) * 1024 + lane * 16) = ao;
}
template <bool ROPE>
__device__ __forceinline__ void tile_build_bf16(unsigned char* dst, const bf16* k0, int kld, const bf16* v0, int vld, int r, int lane, const float* ropetab, int posrow, int poscol0) {
    const int c = lane & 15, g = lane >> 4, keyblk = r >> 1, kkb = 2 * (r & 1);
    const bf16* kp = k0 + (size_t)(16 * keyblk + c) * kld + 8 * g;
    bf16x8 ka = ld8(kp + 32 * kkb), kb = ld8(kp + 32 * (kkb + 1));
    unsigned vw[8]; const int s = r >> 2, dq = r & 3;
#pragma unroll
    for (int j = 0; j < 8; ++j) { const int key = 32 * s + 16 * (j >> 2) + 4 * g + (j & 3); vw[j] = *(const unsigned*)(v0 + (size_t)key * vld + 32 * dq + 2 * c); }
    if (ROPE) { const int pos = (r & 1) ? (poscol0 + 16 * keyblk + c) : posrow; const f32x4* tab = (const f32x4*)(ropetab + (pos * 32 + 8 * g) * 2);
        u32x4 wa, wb;
#pragma unroll
        for (int jp = 0; jp < 4; ++jp) { const f32x4 t4 = tab[jp];
            const float a0 = bf2f((unsigned short)ka[2 * jp]), a1 = bf2f((unsigned short)ka[2 * jp + 1]), b0 = bf2f((unsigned short)kb[2 * jp]), b1 = bf2f((unsigned short)kb[2 * jp + 1]);
            wa[jp] = pk2(a0 * t4[0] - b0 * t4[1], a1 * t4[2] - b1 * t4[3]); wb[jp] = pk2(b0 * t4[0] + a0 * t4[1], b1 * t4[2] + a1 * t4[3]); }
        ka = __builtin_bit_cast(bf16x8, wa); kb = __builtin_bit_cast(bf16x8, wb); }
    *(bf16x8*)(dst + (2 * r) * 1024 + lane * 16) = ka; *(bf16x8*)(dst + (2 * r + 1) * 1024 + lane * 16) = kb;
    vfrag_store(dst, vw, r, lane);
}
struct TileRole { bf16x8 ka, kb; unsigned vw[8]; };
__device__ __forceinline__ void tile_role_load(TileRole& T, const bf16* k0, int kld, const bf16* v0, int vld, int r, int lane) {
    const int c = lane & 15, g = lane >> 4, keyblk = r >> 1, kkb = 2 * (r & 1), s = r >> 2, dq = r & 3;
    const bf16* kp = k0 + (size_t)(16 * keyblk + c) * kld + 8 * g;
    T.ka = ld8(kp + 32 * kkb); T.kb = ld8(kp + 32 * (kkb + 1));
#pragma unroll
    for (int j = 0; j < 8; ++j) { const int key = 32 * s + 16 * (j >> 2) + 4 * g + (j & 3); T.vw[j] = *(const unsigned*)(v0 + (size_t)key * vld + 32 * dq + 2 * c); }
}
__device__ __forceinline__ void tile_role_store(const TileRole& T, unsigned char* dst, int r, int lane) {
    *(bf16x8*)(dst + (2 * r) * 1024 + lane * 16) = T.ka; *(bf16x8*)(dst + (2 * r + 1) * 1024 + lane * 16) = T.kb;
    vfrag_store(dst, T.vw, r, lane);
}
__device__ __forceinline__ void tile_build_f32(unsigned char* dst, const float* k0, const float* v0, int ld, int r, int lane) {
    const int c = lane & 15, g = lane >> 4, keyblk = r >> 1, kkb = 2 * (r & 1);
    const float* kp = k0 + (size_t)(16 * keyblk + c) * ld + 8 * g;
    const bf16x8 ka = ld8_f32(kp + 32 * kkb), kb = ld8_f32(kp + 32 * (kkb + 1));
    unsigned vw[8]; const int s = r >> 2, dq = r & 3;
#pragma unroll
    for (int j = 0; j < 8; ++j) { const int key = 32 * s + 16 * (j >> 2) + 4 * g + (j & 3); const f32x2_t v = *(const f32x2_t*)(v0 + (size_t)key * ld + 32 * dq + 2 * c); vw[j] = pk2(v[0], v[1]); }
    *(bf16x8*)(dst + (2 * r) * 1024 + lane * 16) = ka; *(bf16x8*)(dst + (2 * r + 1) * 1024 + lane * 16) = kb;
    vfrag_store(dst, vw, r, lane);
}
__device__ __forceinline__ void cache_tiles(Frame& F) {
    FRESH_IDS();
    const int gw = F.bid * NWAVES + wave, NGW = F.G * NWAVES;
    for (int job = gw; job < 320 * 8; job += NGW) { const int tile = job >> 3, r = job & 7;
        if (tile < 64) { const int t = tile & 3, kvh = (tile >> 2) & 1, b = (tile >> 3) & 3, e = tile >> 5;
            const float* k0 = F.in[3] + ((size_t)((b * 2 + e) * 2 + 0) * 256 + 64 * t) * 256 + kvh * 128;
            tile_build_f32(F.ws + WS_TCACHE_E + (size_t)tile * AT_TILE, k0, k0 + 65536, 256, r, lane); }
        else { const int tl = tile - 64, t = tl & 3, h = (tl >> 2) & 7, b = (tl >> 5) & 3, o = tl >> 7;
            const float* k0 = F.in[5] + ((size_t)((b * 2 + o) * 2 + 0) * 256 + 64 * t) * 1024 + h * 128;
            tile_build_f32(F.ws + WS_TCACHE_O + (size_t)tl * AT_TILE, k0, k0 + 262144, 1024, r, lane); } }
}
__device__ __forceinline__ void kv_tiles(Frame& F, int li) {
    FRESH_IDS();
    const int gw = F.bid * NWAVES + wave, NGW = F.G * NWAVES;
    const bf16* P = (const bf16*)(F.ws + WS_P);
    if (li & 1) {
        for (int job0 = gw; job0 < 1024 * 8; job0 += 4 * NGW) {
            TileRole T[4]; unsigned char* dst[4]; int rr[4]; bool ok[4];
#pragma unroll
            for (int q = 0; q < 4; ++q) { const int job = job0 + q * NGW; ok[q] = job < 1024 * 8; const int tile = (ok[q] ? job : job0) >> 3; rr[q] = (ok[q] ? job : job0) & 7;
                const bf16* k0;
                if (tile < 512) { const int t = tile & 3, h = (tile >> 2) & 7, b = tile >> 5; k0 = P + (size_t)(b * 256 + 64 * t) * LDP_O + O_KD + h * 128; dst[q] = F.ws + WS_TCTX + (size_t)tile * AT_TILE; }
                else { const int tl = tile - 512, row = tl & 15, h = (tl >> 4) & 7, b = tl >> 7; k0 = P + (size_t)(MCTX + b * 1024 + 64 * row) * LDP_O + O_KD + h * 128; dst[q] = F.ws + WS_TLAT + (size_t)tl * AT_TILE; }
                tile_role_load(T[q], k0, LDP_O, k0 + (O_VD - O_KD), LDP_O, rr[q], lane); }
#pragma unroll
            for (int q = 0; q < 4; ++q) if (ok[q]) tile_role_store(T[q], dst[q], rr[q], lane);
        }
    } else {
        for (int job = gw; job < 256 * 8; job += NGW) { const int tile = job >> 3, r = job & 7;
            if (tile < 128) { const int t = tile & 3, kvh = (tile >> 2) & 1, b = tile >> 3;
                const bf16* k0 = P + (size_t)(b * 256 + 64 * t) * LDP_E + E_KB + kvh * 128;
                tile_build_bf16<false>(F.ws + WS_TCTX + (size_t)tile * AT_TILE, k0, LDP_E, k0 + (E_VB - E_KB), LDP_E, r, lane, nullptr, 0, 0); }
            else { const int tl = tile - 128, t = tl & 15, kvh = (tl >> 4) & 1, b = tl >> 5;
                const bf16* k0 = P + (size_t)(MCTX + b * 1024 + 64 * t) * LDP_E + E_KB + kvh * 128;
                tile_build_bf16<true>(F.ws + WS_TLAT + (size_t)tl * AT_TILE, k0, LDP_E, k0 + (E_VB - E_KB), LDP_E, r, lane, (const float*)(F.ws + WS_ROPE), t, 0); } }
    }
}

struct AttnState { f32x4 o[4][2]; float m, l; };
__device__ __forceinline__ void attn_step(AttnState& st, const bf16x8 (&qf)[4], const unsigned char* buf, int s, const float (&bias)[8], unsigned okmask, int lane) {
    const unsigned char* lb = buf + lane * 16;
    bf16x8 kf[2][4], vf[4][2];
#pragma unroll
    for (int hf = 0; hf < 2; ++hf)
#pragma unroll
        for (int kk = 0; kk < 4; ++kk) kf[hf][kk] = *(const bf16x8*)(lb + ((2 * s + hf) * 4 + kk) * 1024);
#pragma unroll
    for (int dq = 0; dq < 4; ++dq)
#pragma unroll
        for (int par = 0; par < 2; ++par) vf[dq][par] = *(const bf16x8*)(lb + AT_V + ((s * 4 + dq) * 2 + par) * 1024);
    __builtin_amdgcn_sched_barrier(0);
    f32x4 sc[2];
#pragma unroll
    for (int hf = 0; hf < 2; ++hf) { sc[hf] = (f32x4){0.f, 0.f, 0.f, 0.f};
#pragma unroll
        for (int kk = 0; kk < 4; ++kk) sc[hf] = mfma16(kf[hf][kk], qf[kk], sc[hf]); }
    float v[8]; float mx = -3.0e38f;
#pragma unroll
    for (int idx = 0; idx < 8; ++idx) { v[idx] = sc[idx >> 2][idx & 3] * ATT_SCALE + bias[idx]; if ((okmask >> idx) & 1u) mx = fmaxf(mx, v[idx]); }
    mx = xmax<16>(mx); mx = xmax<32>(mx);
    if (!__all(mx <= st.m + 8.f)) { const float mnew = fmaxf(st.m, mx), alpha = __expf(st.m - mnew); st.m = mnew; st.l *= alpha;
#pragma unroll
        for (int dq = 0; dq < 4; ++dq)
#pragma unroll
            for (int par = 0; par < 2; ++par) st.o[dq][par] = st.o[dq][par] * alpha; }
    const float mcur = st.m;
    float ps = 0.f; f32x4 p0, p1;
#pragma unroll
    for (int idx = 0; idx < 8; ++idx) { const float p = ((okmask >> idx) & 1u) ? __expf(v[idx] - mcur) : 0.f; ps += p; if (idx < 4) p0[idx] = p; else p1[idx - 4] = p; }
    ps = xsum<16>(ps); ps = xsum<32>(ps);
    st.l += ps;
    const bf16x8 pb = pack_acc(p0, p1);
#pragma unroll
    for (int dq = 0; dq < 4; ++dq)
#pragma unroll
        for (int par = 0; par < 2; ++par) st.o[dq][par] = mfma16(vf[dq][par], pb, st.o[dq][par]);
}
__device__ __forceinline__ void attn_init(AttnState& st, bool has_sink, float sink) {
#pragma unroll
    for (int dq = 0; dq < 4; ++dq) { st.o[dq][0] = (f32x4){0.f, 0.f, 0.f, 0.f}; st.o[dq][1] = (f32x4){0.f, 0.f, 0.f, 0.f}; }
    st.m = has_sink ? sink : -1.0e30f; st.l = has_sink ? 1.f : 0.f;
}
__device__ __forceinline__ void attn_load_q(bf16x8 (&qf)[4], const bf16* qrow, int g) {
#pragma unroll
    for (int kk = 0; kk < 4; ++kk) qf[kk] = ld8(qrow + 32 * kk + 8 * g);
}
template <bool GATE>
__device__ __forceinline__ void attn_finish(const AttnState& st, const bf16x8 (&z)[4], bf16* orow, int g) {
    const float il = __builtin_amdgcn_rcpf(st.l);
#pragma unroll
    for (int dq = 0; dq < 4; ++dq) {
        u32x4 w;
#pragma unroll
        for (int r = 0; r < 4; ++r) { const float a = st.o[dq][0][r] * il * (GATE ? siluf(bf2f((unsigned short)z[dq][2 * r])) : 1.f), b = st.o[dq][1][r] * il * (GATE ? siluf(bf2f((unsigned short)z[dq][2 * r + 1])) : 1.f);
            w[r] = pk2(a, b); }
        *(u32x4*)(orow + 32 * dq + 8 * g) = w; }
}

constexpr int AT_RPB = 131072;
template <int MODE>
__device__ __forceinline__ void attn_unit(Frame& F, int eo, int u) {
    FRESH_IDS();
    const int c = lane & 15, g = lane >> 4;
    const bf16* P = (const bf16*)(F.ws + WS_P);
    constexpr int LDP = (MODE < 2) ? LDP_E : LDP_O;
    int b, hq, m, nt, q0 = 0, rr = 0, jb = 0, rs0 = 0, rsw = 0, kvh = 0;
    const bf16* qrow; const bf16* zrow;
    if (MODE == 0 || MODE == 2) { b = u >> 4; hq = (u >> 1) & 7; m = b * 256 + (u & 1) * 128 + wave * 16 + c; nt = 4; }
    else if (MODE == 1) { b = u >> 6; hq = (u >> 3) & 7; q0 = (u & 7) * 128; m = MCTX + b * 1024 + q0 + wave * 16 + c;
        int t0 = q0 - 128; if (t0 < 0) t0 = 0; int t1 = q0 + 256; if (t1 > 1024) t1 = 1024; rs0 = t0; nt = 4 + (t1 - t0) / 64; }
    else { b = u >> 6; hq = (u >> 3) & 7; const int rp = u & 7; rr = 2 * rp + (wave >> 2); jb = wave & 3; m = MCTX + b * 1024 + rr * 64 + 16 * jb + c;
        rs0 = 2 * rp - 4; rs0 = rs0 < 0 ? 0 : (rs0 > 8 ? 8 : rs0); int rs1 = 2 * rp - 3; rs1 = rs1 < 0 ? 0 : (rs1 > 8 ? 8 : rs1);
        rsw = rr - 4; rsw = rsw < 0 ? 0 : (rsw > 8 ? 8 : rsw); nt = 4 + (rs1 + 8 - rs0); }
    if (MODE == 0) { kvh = hq >> 2; qrow = P + (size_t)m * LDP + E_QB + hq * 128; zrow = P + (size_t)m * LDP + E_ZB + hq * 128; }
    else if (MODE == 1) { kvh = hq >> 2; qrow = (const bf16*)(F.ws + WS_QR) + (size_t)(m - MCTX) * 1024 + hq * 128; zrow = P + (size_t)m * LDP + E_ZB + hq * 128; }
    else { qrow = P + (size_t)m * LDP + O_QD + hq * 128; zrow = P + (size_t)m * LDP + O_ZD + hq * 128; }
    (void)kvh; (void)q0; (void)rr; (void)jb; (void)rsw;
    auto tile_ptr = [&](int t) -> const unsigned char* {
        if (MODE == 0) return F.ws + WS_TCTX + (size_t)((b * 2 + kvh) * 4 + t) * AT_TILE;
        if (MODE == 2) return F.ws + WS_TCTX + (size_t)((b * 8 + hq) * 4 + t) * AT_TILE;
        if (MODE == 1) return (t < 4) ? F.ws + WS_TCACHE_E + (size_t)(((eo * 4 + b) * 2 + kvh) * 4 + t) * AT_TILE
                                      : F.ws + WS_TLAT + (size_t)((b * 2 + kvh) * 16 + (rs0 >> 6) + (t - 4)) * AT_TILE;
        return (t < 4) ? F.ws + WS_TCACHE_O + (size_t)(((eo * 4 + b) * 8 + hq) * 4 + t) * AT_TILE
                       : F.ws + WS_TLAT + (size_t)((b * 8 + hq) * 16 + rs0 + (t - 4)) * AT_TILE; };
    auto tile_dma = [&](int t) { const unsigned char* src = tile_ptr(t); LAS unsigned char* dst = F.lds + (t & 3) * AT_TILE;
#pragma unroll
        for (int i = 0; i < 4; ++i) __builtin_amdgcn_global_load_lds((const unsigned*)(src + (wave + 8 * i) * 1024 + lane * 16), (LAS unsigned*)(dst + (wave + 8 * i) * 1024), 16, 0, 0); };
    asm volatile("s_waitcnt vmcnt(0)" ::: "memory");
    __syncthreads();
    tile_dma(0); tile_dma(1); tile_dma(2);
    bf16x8 qf[4]; attn_load_q(qf, qrow, g);
    bf16x8 zf[4];
#pragma unroll
    for (int dq = 0; dq < 4; ++dq) { if (MODE < 2) zf[dq] = ld8(zrow + 32 * dq + 8 * g); else zf[dq] = (bf16x8){0, 0, 0, 0, 0, 0, 0, 0}; }
    const float sinkv = (MODE < 2) ? F.in[16][eo * 8 + hq] : 0.f;
    if (MODE == 3) { float* rt = (float*)(F.smem + AT_RPB); for (int i = tid; i < 465; i += NTHREADS) rt[i] = F.in[22][(size_t)(eo * 8 + hq) * 465 + i]; }
    asm volatile("s_waitcnt vmcnt(0)" : "+v"(qf[0]), "+v"(qf[1]), "+v"(qf[2]), "+v"(qf[3]), "+v"(zf[0]), "+v"(zf[1]), "+v"(zf[2]), "+v"(zf[3]) :: "memory");
    AttnState st; attn_init(st, MODE < 2, sinkv);
#pragma unroll 1
    for (int t = 0; t < nt; ++t) {
        const int rem = nt - 1 - t;
        if (rem >= 2) asm volatile("s_waitcnt vmcnt(8)" ::: "memory"); else if (rem == 1) asm volatile("s_waitcnt vmcnt(4)" ::: "memory"); else asm volatile("s_waitcnt vmcnt(0)" ::: "memory");
        asm volatile("s_waitcnt lgkmcnt(0)" ::: "memory");
        __builtin_amdgcn_s_barrier();
        asm volatile("" ::: "memory");
        if (t + 3 < nt) tile_dma(t + 3);
        const unsigned char* buf = F.smem + (t & 3) * AT_TILE;
        if (MODE == 0 || MODE == 2 || t < 4) {
            const float zb[8] = {0.f, 0.f, 0.f, 0.f, 0.f, 0.f, 0.f, 0.f};
            attn_step(st, qf, buf, 0, zb, 0xffu, lane); attn_step(st, qf, buf, 1, zb, 0xffu, lane);
        } else if (MODE == 1) {
            int gg = g; asm volatile("" : "+v"(gg));
            const int tk0 = rs0 + 64 * (t - 4), tq = q0 + wave * 16 + c; const float zb[8] = {0.f, 0.f, 0.f, 0.f, 0.f, 0.f, 0.f, 0.f};
#pragma unroll
            for (int s = 0; s < 2; ++s) {
                const int ks = tk0 + 32 * s, tqw = q0 + wave * 16;
                if (ks > tqw + 15 + 128 || ks + 31 < tqw - 128) continue;
                unsigned ok = 0u;
#pragma unroll
                for (int idx = 0; idx < 8; ++idx) { const int dd = tq - (tk0 + 32 * s + 16 * (idx >> 2) + 4 * gg + (idx & 3)); if (dd <= 128 && dd >= -128) ok |= 1u << idx; }
                attn_step(st, qf, buf, s, zb, ok, lane); }
        } else {
            const int R_ = rs0 + t - 4;
            if (R_ >= rsw && R_ < rsw + 8) {
                int gg = g; asm volatile("" : "+v"(gg));
                const float* rp = (const float*)(F.smem + AT_RPB) + (R_ - rr + 7) * 31;
                const int qc = 16 * jb + c; int cstart = qc - 8; cstart = cstart < 0 ? 0 : (cstart > 48 ? 48 : cstart);
#pragma unroll
                for (int s = 0; s < 2; ++s) { if ((jb == 0 && s == 1) || (jb == 3 && s == 0)) continue;
                    float bias[8]; unsigned ok = 0u;
#pragma unroll
                    for (int idx = 0; idx < 8; ++idx) { const int kcol = 32 * s + 16 * (idx >> 2) + 4 * gg + (idx & 3); int dc = kcol - qc; dc = dc < -15 ? -15 : (dc > 15 ? 15 : dc);
                        bias[idx] = rp[dc + 15]; if (kcol >= cstart && kcol < cstart + 16) ok |= 1u << idx; }
                    attn_step(st, qf, buf, s, bias, ok, lane); }
            }
        }
    }
    attn_finish<(MODE < 2)>(st, zf, (bf16*)(F.ws + WS_OMIX) + (size_t)m * DM + 1024 + hq * 128, g);
}

constexpr int N_PHASES = 26;

__device__ __forceinline__ void phase_gemm_in(Frame& F, int li) {
    unsigned char* ws = F.ws; asm volatile("" : "+s"(ws));
    const int e = li >> 1; const bool odd = li & 1;
    const int NP = odd ? NP_O : NP_E, LDP = odd ? LDP_O : LDP_E;
    const bf16* WT = (const bf16*)(ws + (odd ? WS_WIN_O + e * WIN_O_BYTES : WS_WIN_E + e * WIN_E_BYTES));
    pg8::Gemm gm{(const pg8::bf16_t*)(ws + WS_H), (const pg8::bf16_t*)WT, MROWS, NP, DM};
    pg8::SubsetOrder S; S.init(MROWS, 24 * 256, F.G, F.bid); S.odd = odd ? 1 : 0;
    pg8::EpiInProj E{(pg8::bf16_t*)(ws + WS_P), LDP, (float*)(ws + WS_SM), NP / 256 - 1};
    pg8::gemm_phase<pg8::EpiInProj, pg8::SubsetOrder, true, true>(F.lds, gm, S, E);
}
__device__ __forceinline__ void gemm_in_tile(Frame& F, int li, int idx) {
    unsigned char* ws = F.ws; asm volatile("" : "+s"(ws));
    const int e = li >> 1; const bool odd = li & 1;
    const int NP = odd ? NP_O : NP_E, LDP = odd ? LDP_O : LDP_E;
    const bf16* WT = (const bf16*)(ws + (odd ? WS_WIN_O + e * WIN_O_BYTES : WS_WIN_E + e * WIN_E_BYTES));
    pg8::Gemm gm{(const pg8::bf16_t*)(ws + WS_H), (const pg8::bf16_t*)WT, MROWS, NP, DM};
    pg8::SingleOrder S; if (odd) { const int j = idx % 5; S.pm = idx / 5; S.pn = (j < 4) ? 8 + j : 24; } else { S.pm = idx / 3; S.pn = 12 + idx % 3; }
    pg8::EpiInProj E{(pg8::bf16_t*)(ws + WS_P), LDP, (float*)(ws + WS_SM), NP / 256 - 1};
    __syncthreads();
    pg8::gemm_phase<pg8::EpiInProj, pg8::SingleOrder, true, true>(F.lds, gm, S, E);
}
__device__ __forceinline__ void phase_gemm_out(Frame& F, int li) {
    unsigned char* ws = F.ws; asm volatile("" : "+s"(ws));
    pg8::Gemm gm{(const pg8::bf16_t*)(ws + WS_OMIX), (const pg8::bf16_t*)(ws + WS_WOUT + li * WOUT_BYTES), MROWS, DM, DM};
    pg8::StaticOrder S; S.init(MROWS, DM, F.G, F.bid);
    float* X = (float*)(ws + WS_X);
    pg8::EpiOutProj E{li == 0 ? F.in[0] : X, li == 0 ? F.in[1] : X + (size_t)MCTX * DM, X, (const float*)(ws + WS_MOD) + (size_t)li * 5 * 6144 + 4096};
    pg8::gemm_phase<pg8::EpiOutProj, pg8::StaticOrder, true, true>(F.lds, gm, S, E);
}
__device__ __forceinline__ void phase_prep(Frame& F, int li) {
    const int e = li >> 1;
    if (li & 1) { for (int u = F.bid; u < 512; u += F.G) gla_prep_unit(F, e, u >> 2, u & 3); }
    else {
        if (F.bid < 1024) { int tidf = F.tid; asm volatile("" : "+v"(tidf));
            ConvIn C; delta_conv_load(F, C, e, F.bid >> 3, F.bid & 7, tidf);
            for (int u = F.bid; u < 1024; u += F.G) { const int un = u + F.G; delta_prep_unit(F, e, u >> 3, u & 7, C, (un < 1024 && (un & 7) == (u & 7)) ? (un >> 3) : -1);
                if (un < 1024 && (un & 7) != (u & 7)) { int t2 = F.tid; asm volatile("" : "+v"(t2)); delta_conv_load(F, C, e, un >> 3, un & 7, t2); } } }
        FRESH_IDS();
        const int gw = F.bid * NWAVES + wave, NGW = F.G * NWAVES;
        for (int lt = gw; lt < 4096; lt += NGW) rope_token(F, lt);
    }
    kv_tiles(F, li);
}
__device__ __forceinline__ int queue_fetch(unsigned* ctr) { return (int)__hip_atomic_fetch_add(ctr, 1u, __ATOMIC_RELAXED, __HIP_MEMORY_SCOPE_AGENT); }
__device__ __forceinline__ void phase_scan_attn(Frame& F, int li, int part, int rep) {
    const int e = li >> 1;
    unsigned* ctr = (unsigned*)(F.ws + WS_CTL) + 1024 + 64 * (li * 2 + rep);
    const int NG = (li & 1) ? 160 : 96;
    volatile LAS int* slot = (volatile LAS int*)(F.lds + LDS_MISC + 64);
    int nxt = 0; if (F.tid == 0) nxt = queue_fetch(ctr);
    for (int k = 0;; ++k) {
        if (F.tid == 0) slot[k & 1] = nxt;
        __syncthreads();
        int u = slot[k & 1];
        if (F.tid == 0) nxt = queue_fetch(ctr);
        if (u >= 832 + NG) break;
        if (u >= 64) { if (u < 64 + NG) { if (part == 0) gemm_in_tile(F, li, u - 64); continue; } u -= NG; }
        if (li & 1) {
            if (u < 64) { if (part != 2) gla_scan_unit(F, e, 128 + (u >> 1), u & 1); }
            else if (u < 576) { if (part != 1) { const int au = u - 64; if (au < 256) attn_unit<3>(F, e, au); else attn_unit<2>(F, e, au - 256); } }
            else { if (part != 2) { const int cu = u - 576; gla_scan_unit(F, e, cu >> 1, cu & 1); } }
        } else {
            if (u < 64) { if (part != 2) delta_scan_unit(F, e, 256 + u); }
            else if (u < 576) { if (part != 1) { const int au = u - 64; if (au < 256) attn_unit<1>(F, e, au); else attn_unit<0>(F, e, au - 256); } }
            else { if (part != 2) delta_scan_unit(F, e, u - 576); }
        }
    }
}

#define XB_TMO      128
#define XB_XCNT(j)  (256  + 64 * (j))
#define XB_XSUB(j)  (1280 + 64 * (j))
#define XB_XGEN(j)  (2304 + 64 * (j))
#define XB_TOP      3328
#define XB_TOPGEN   3392
#define XCD_BAR_WORDS 3456
#define XB_SPIN_CAP (1u << 18)

__device__ __forceinline__ unsigned xb_ld(unsigned* p)              { return __hip_atomic_load(p, __ATOMIC_RELAXED, __HIP_MEMORY_SCOPE_AGENT); }
__device__ __forceinline__ unsigned xb_add(unsigned* p, unsigned v) { return __hip_atomic_fetch_add(p, v, __ATOMIC_RELAXED, __HIP_MEMORY_SCOPE_AGENT); }
__device__ __forceinline__ unsigned xb_xcc_id() { return (unsigned)__builtin_amdgcn_s_getreg((3 << 11) | 20) & 0xFu; }
#define XB_SPIN(cond, bar) do { unsigned _sp = 0; while (cond) { __builtin_amdgcn_s_sleep(1); \
    if ((++_sp & 255u) == 0u) { if (xb_ld(&(bar)[XB_TMO])) break; if (_sp > XB_SPIN_CAP) { atomicAdd(&(bar)[XB_TMO], 1u); break; } } } } while (0)

struct XcdBarrier {
    unsigned* bar; unsigned x;
    volatile LAS unsigned* st;
};

__device__ __forceinline__ XcdBarrier xcd_barrier_post(unsigned* bar, volatile LAS unsigned* st) {
    XcdBarrier b; b.bar = bar; b.x = xb_xcc_id(); b.st = st;
    if (threadIdx.x == 0) (void)xb_add(&bar[XB_XCNT(b.x)], 1u);
    return b;
}
__device__ __forceinline__ void xcd_barrier_complete(unsigned* bar, unsigned x, unsigned& nloc, unsigned& nx) {
    const unsigned G = gridDim.x * gridDim.y * gridDim.z;
    unsigned sum, cnt, mine, sp = 0u;
    for (;;) {
        sum = 0u; cnt = 0u; mine = 0u;
#pragma unroll
        for (unsigned j = 0; j < 16; ++j) { const unsigned c = xb_ld(&bar[XB_XCNT(j)]); sum += c; cnt += (c > 0u) ? 1u : 0u; mine = (j == x) ? c : mine; }
        if (sum == G) break;
        __builtin_amdgcn_s_sleep(1);
        if ((++sp & 255u) == 0u) { if (xb_ld(&bar[XB_TMO])) break; if (sp > XB_SPIN_CAP) { atomicAdd(&bar[XB_TMO], 1u); break; } }
    }
    nloc = mine > 0u ? mine : 1u; nx = cnt > 0u ? cnt : 1u;
}

__device__ __forceinline__ void xcd_barrier(const XcdBarrier& b) {
    asm volatile("s_waitcnt vmcnt(0)" ::: "memory");
    __syncthreads();
    if (threadIdx.x == 0) {
        unsigned* bar = b.bar;
        __builtin_amdgcn_s_waitcnt(0);
        unsigned nloc = b.st[0], nx = b.st[1];
        if (nloc == 0u) { xcd_barrier_complete(bar, b.x, nloc, nx); b.st[0] = nloc; b.st[1] = nx; }
        const unsigned old = xb_add(&bar[XB_XSUB(b.x)], 1u);
        const unsigned gen = old / nloc;
        if (old + 1u == (gen + 1u) * nloc) {
            __builtin_amdgcn_fence(__ATOMIC_RELEASE, "agent");
            asm volatile("s_waitcnt vmcnt(0)" ::: "memory");
            const unsigned og = xb_add(&bar[XB_TOP], 1u);
            const unsigned tg = og / nx;
            if (og + 1u == (tg + 1u) * nx) xb_add(&bar[XB_TOPGEN], 1u);
            else XB_SPIN(xb_ld(&bar[XB_TOPGEN]) == tg, bar);
            __builtin_amdgcn_fence(__ATOMIC_ACQUIRE, "agent");
            xb_add(&bar[XB_XGEN(b.x)], 1u);
            asm volatile("s_waitcnt vmcnt(0)" ::: "memory");
        } else {
            XB_SPIN(xb_ld(&bar[XB_XGEN(b.x)]) == gen, bar);
            __builtin_amdgcn_fence(__ATOMIC_ACQUIRE, "agent");
            asm volatile("s_waitcnt vmcnt(0)" ::: "memory");
        }
    }
    __syncthreads();
}


#ifdef NO_PRO
#define PH_PRO(x)
#else
#define PH_PRO(x) x
#endif
#ifdef NO_FN
#define PH_FN(x)
#else
#define PH_FN(x) x
#endif
#ifdef NO_NORM
#define PH_NORM(x)
#else
#define PH_NORM(x) x
#endif
#ifdef NO_GIN
#define PH_GIN(x)
#else
#define PH_GIN(x) x
#endif
#ifdef NO_PREP
#define PH_PREP(x)
#else
#define PH_PREP(x) x
#endif
#ifdef NO_SCAN
#define PH_SCAN(x)
#else
#define PH_SCAN(x) x
#endif
#ifdef NO_COMB
#define PH_COMB(x)
#else
#define PH_COMB(x) x
#endif
#ifdef NO_GOUT
#define PH_GOUT(x)
#else
#define PH_GOUT(x) x
#endif
__global__ void __launch_bounds__(NTHREADS, 2) fwd_kernel(Args args) {
    extern __shared__ __attribute__((aligned(16))) unsigned char lds_raw[];
    Frame F;
    F.lds = (LAS unsigned char*)lds_raw; F.smem = lds_raw;
    F.tid = threadIdx.x; F.G = gridDim.x; F.bid = blockIdx.x; F.in = args.in;
    F.out = args.out; F.ws = args.ws;
    for (int u = F.tid; u < 64; u += NTHREADS) ((LAS unsigned*)(F.lds + LDS_MISC))[u] = 0u;
    __syncthreads();
    XcdBarrier bar = xcd_barrier_post((unsigned*)(F.ws + WS_CTL) + 4096, (volatile LAS unsigned*)(F.lds + LDS_MISC) + 8);
#pragma unroll 1
    for (int ph = args.ph_lo; ph < args.ph_hi; ++ph) {
        int nrep = 1;
#ifndef DUP_PART
#define DUP_PART 0
#endif
#ifndef DUP_LAYERS
#define DUP_LAYERS 15
#endif
#ifdef DUP_SUB
        if (DUP_SUB == 6) { if (ph == 0) nrep = 2; }
        else if (ph > 0 && ph < N_PHASES - 1 && (ph - 1) % 6 == DUP_SUB && (DUP_SUB != 5 || ph == 6) && ((DUP_LAYERS >> ((ph - 1) / 6)) & 1)) nrep = 2;
#endif
#pragma unroll 1
        for (int rep = 0; rep < nrep; ++rep) {
        if (rep) xcd_barrier(bar);
        if (ph == 0) { PH_PRO(phase_prologue(F); rope_table(F); cache_tiles(F)); }
        else if (ph == N_PHASES - 1) { PH_FN(phase_final_norm(F)); }
        else { const int li = (ph - 1) / 6, sub = (ph - 1) % 6;
            if (sub == 0) { PH_NORM(phase_norm(F, li)); }
            else if (sub == 1) { PH_GIN(phase_gemm_in(F, li)); }
            else if (sub == 2) { PH_PREP(phase_prep(F, li)); }
            else if (sub == 3) { PH_SCAN(phase_scan_attn(F, li, rep ? DUP_PART : 0, rep)); }
            else if (sub == 4) { PH_COMB(if (li & 1) phase_combine_odd(F, li >> 1); else phase_combine_even(F, li >> 1)); }
            else { PH_GOUT(phase_gemm_out(F, li)); }
        }
        }
        if (ph + 1 < args.ph_hi) { if (args.pad != 0) cg::this_grid().sync();
            xcd_barrier(bar); }
        __syncthreads();
    }
}

extern "C" void kernel_launch(void* const* d_in, const int* in_sizes, int n_in, void* d_out, int out_size, void* d_ws, size_t ws_size, hipStream_t stream) {
    static int grid = 0;
    if (grid == 0) {
        if (n_in != 25 || (size_t)out_size != OUT_TOTAL || ws_size < WS_END) { fprintf(stderr, "kernel_launch: unexpected problem (n_in %d, out %d, ws %zu)\n", n_in, out_size, ws_size); grid = -1; return; }
        int dev = 0, cus = 0;
        if (hipGetDevice(&dev) != hipSuccess || hipDeviceGetAttribute(&cus, hipDeviceAttributeMultiprocessorCount, dev) != hipSuccess) { grid = -1; return; }
        if (hipFuncSetAttribute((const void*)fwd_kernel, hipFuncAttributeMaxDynamicSharedMemorySize, LDS_BYTES) != hipSuccess) { fprintf(stderr, "kernel_launch: hipFuncSetAttribute failed\n"); grid = -1; return; }
        int per_cu = 0;
        if (hipOccupancyMaxActiveBlocksPerMultiprocessor(&per_cu, (const void*)fwd_kernel, NTHREADS, LDS_BYTES) != hipSuccess || per_cu < 1) { fprintf(stderr, "kernel_launch: occupancy query says %d\n", per_cu); (void)hipGetLastError(); }
        if (per_cu < 1) per_cu = 1;
        grid = cus * 1;
    }
    if (grid < 0) return;
    (void)hipMemsetAsync((char*)d_ws + WS_CTL, 0, CTL_ZERO_BYTES, stream);
    Args a{};
    for (int i = 0; i < 25; ++i) a.in[i] = (const float*)d_in[i];
    a.out = (float*)d_out; a.ws = (unsigned char*)d_ws; a.coop = 1; a.pad = 0;
    a.ph_lo = 0; a.ph_hi = N_PHASES;
    void* kargs[] = {&a};
    hipError_t e = hipLaunchCooperativeKernel((const void*)fwd_kernel, dim3(grid), dim3(NTHREADS), kargs, LDS_BYTES, stream);
    if (e != hipSuccess) fprintf(stderr, "kernel_launch: cooperative launch failed: %s (grid %d)\n", hipGetErrorString(e), grid);
}
```

```cpp
#include <hip/hip_runtime.h>
#include <hip/hip_cooperative_groups.h>
#include <cstdio>
#include <cstdint>
namespace cg = cooperative_groups;

namespace pg8 {
#define PG8_LAS __attribute__((address_space(3)))
typedef unsigned short bf16_t;
typedef short bf16x8 __attribute__((ext_vector_type(8)));
typedef float f32x4 __attribute__((ext_vector_type(4)));
typedef unsigned u32x4 __attribute__((ext_vector_type(4)));
constexpr int BM = 256, BK = 64, HALF = 128, HTB = HALF * BK * 2  , STAGE_BYTES = 8 * HTB, NXCD = 8, WGM = 8;

__host__ __device__ __forceinline__ int lds_byte(int r, int c) { const int st = (r >> 4) * 2 + (c >> 5), rr = r & 15, cc = c & 31, ob = rr * 64 + cc * 2; return st * 1024 + (ob ^ (((ob >> 9) & 1) << 5)); }
__host__ __device__ __forceinline__ void stage_rc(int b, int& R, int& C) { const int st = b / 1024, sb = b % 1024, swz = sb ^ (((sb >> 9) & 1) << 5); R = (st >> 1) * 16 + swz / 64; C = (st & 1) * 32 + (swz % 64) / 2; }
__host__ __device__ __forceinline__ int perm32(int rho) { const int n = rho >> 4, i = rho & 15; return 8 * (i >> 2) + 4 * n + (i & 3); }

struct Unit { int pm, pn; };
#ifdef TPROBE
struct Gemm { const bf16_t* A; const bf16_t* Bt; int M, N, K; unsigned long long* tp; };
#else
struct Gemm { const bf16_t* A; const bf16_t* Bt; int M, N, K; };
#endif

struct StaticOrder {
    int nM, nN, nwg, G, c;
    __host__ __device__ void init(int M, int N, int G_, int c_) { nM = M / BM; nN = N / BM; nwg = nM * nN; G = G_; c = c_; }
    __host__ __device__ bool next(int i, Unit& u) const {
        const long L = (long)i * G + c; if (L >= nwg) return false;
        int wgid = (int)L; { const int q = nwg / NXCD, r = nwg % NXCD, xcd = wgid % NXCD, off = wgid / NXCD; wgid = (xcd < r ? xcd * (q + 1) : r * (q + 1) + (xcd - r) * q) + off; }
        const int nig = WGM * nN, gid = wgid / nig, fm = gid * WGM, gsz = (nM - fm) < WGM ? (nM - fm) : WGM;
        u.pm = fm + ((wgid % nig) % gsz); u.pn = (wgid % nig) / gsz; return true;
    }
    __device__ __forceinline__ void a_ready(const Unit&) const {}
    __device__ __forceinline__ void done(const Unit&) const {}
};
__device__ __forceinline__ unsigned cvt_pk_bf16(float lo, float hi) { unsigned r; asm volatile("v_cvt_pk_bf16_f32 %0, %1, %2" : "=v"(r) : "v"(lo), "v"(hi)); return r; }
template <class Epi, class Sched, bool ALIGN_EPI = false, bool SP2 = false>
__device__ __forceinline__ void gemm_phase(PG8_LAS unsigned char* lds, const Gemm g, const Sched& S, const Epi& E) {
    int tid_l = threadIdx.x; asm volatile("" : "+v"(tid_l));
    const int tid = tid_l, wid = __builtin_amdgcn_readfirstlane(tid >> 6), lane = tid & 63, wr = wid >> 2, wc = wid & 3, fr = lane & 15, fq = lane >> 4;
    const int K = g.K, nt = K / BK;
    unsigned voffA[2], voffB[2];
#pragma unroll
    for (int i = 0; i < 2; ++i) { int R, C; stage_rc(tid * 16 + i * 8192, R, C); const int Rb = Epi::PERM ? ((R & ~31) + perm32(R & 31)) : R;
        voffA[i] = (unsigned)(R * K + C) * 2u; voffB[i] = (unsigned)(Rb * K + C) * 2u; }
    const size_t kstep = (size_t)(BK * 2);
    const size_t hstep = (size_t)HALF * K * 2;
    const size_t tstep = 2 * hstep;
    const unsigned ldsw = (unsigned)wid * 1024u;
    const int aoff = lds_byte(wr * 64 + fr, fq * 8), boff = lds_byte(wc * 32 + fr, fq * 8);
#define PG8_SA(b, h) (((b) * 2 + (h)) * HTB)
#define PG8_SB(b, h) ((4 + (b) * 2 + (h)) * HTB)
#define PG8_STAGE(bufoff, gbase, voff) do { _Pragma("unroll") for (int _i = 0; _i < 2; ++_i) \
        __builtin_amdgcn_global_load_lds((const unsigned*)((const char*)(gbase) + (voff)[_i]), (PG8_LAS unsigned*)(lds + (bufoff) + ldsw + _i * 8192), 16, 0, 0); } while (0)
#define PG8_LDA(dst, b, h) do { _Pragma("unroll") for (int m = 0; m < 4; ++m) _Pragma("unroll") for (int k = 0; k < 2; ++k) dst[m][k] = *(const PG8_LAS bf16x8*)(lds + PG8_SA(b, h) + aoff + m * 2048 + k * 1024); } while (0)
#define PG8_LDB(dst, b, h) do { _Pragma("unroll") for (int n = 0; n < 2; ++n) _Pragma("unroll") for (int k = 0; k < 2; ++k) dst[n][k] = *(const PG8_LAS bf16x8*)(lds + PG8_SB(b, h) + boff + n * 2048 + k * 1024); } while (0)
#define PG8_MMA(ai, bj, At, Bt) do { __builtin_amdgcn_s_setprio(1); _Pragma("unroll") for (int m = 0; m < 4; ++m) _Pragma("unroll") for (int n = 0; n < 2; ++n) _Pragma("unroll") for (int k = 0; k < 2; ++k) \
        acc[ai][bj][m][n] = __builtin_amdgcn_mfma_f32_16x16x32_bf16(Bt[n][k], At[m][k], acc[ai][bj][m][n], 0, 0, 0); __builtin_amdgcn_s_setprio(0); } while (0)
#define PG8_WAIT_V(n) asm volatile("s_waitcnt vmcnt(" #n ")" ::: "memory")
#define PG8_WAIT_L(n) asm volatile("s_waitcnt lgkmcnt(" #n ")" ::: "memory")
#define PG8_BAR __builtin_amdgcn_s_barrier()
#define PG8_SCHED __builtin_amdgcn_sched_barrier(0)
    Unit cur, nxt; int ui = 0;
    if (!S.next(0, cur)) return;
    f32x4 acc[2][2][4][2];
#pragma unroll
    for (int a = 0; a < 2; ++a)
#pragma unroll
        for (int b = 0; b < 2; ++b)
#pragma unroll
            for (int m = 0; m < 4; ++m)
#pragma unroll
                for (int n = 0; n < 2; ++n) acc[a][b][m][n] = (f32x4){0.f, 0.f, 0.f, 0.f};
    bf16x8 At[4][2], B0[2][2], B1[2][2];
    const char* cA = (const char*)g.A + (size_t)cur.pm * tstep; const char* cB = (const char*)g.Bt + (size_t)cur.pn * tstep;
    S.a_ready(cur);
    if constexpr (SP2) {
        PG8_STAGE(PG8_SB(0, 0), cB, voffB); PG8_STAGE(PG8_SB(0, 1), cB + hstep, voffB); PG8_STAGE(PG8_SA(0, 0), cA, voffA); PG8_STAGE(PG8_SA(0, 1), cA + hstep, voffA);
        if (wr == 1) PG8_BAR;
        PG8_WAIT_V(2); PG8_BAR;
        PG8_STAGE(PG8_SB(1, 0), cB + kstep, voffB); PG8_STAGE(PG8_SA(1, 0), cA + kstep, voffA); PG8_STAGE(PG8_SB(1, 1), cB + hstep + kstep, voffB);
        PG8_WAIT_V(6); PG8_BAR;
    } else {
        PG8_STAGE(PG8_SB(0, 0), cB, voffB); PG8_STAGE(PG8_SA(0, 0), cA, voffA); PG8_STAGE(PG8_SB(0, 1), cB + hstep, voffB); PG8_STAGE(PG8_SA(0, 1), cA + hstep, voffA);
        if (wr == 1) PG8_BAR;
        PG8_WAIT_V(4); PG8_BAR;
        PG8_STAGE(PG8_SB(1, 0), cB + kstep, voffB); PG8_STAGE(PG8_SA(1, 0), cA + kstep, voffA); PG8_STAGE(PG8_SB(1, 1), cB + hstep + kstep, voffB);
        PG8_WAIT_V(6); PG8_BAR;
    }
    for (;;) {
        const bool has_next = S.next(ui + 1, nxt);
        const char* nA = has_next ? (const char*)g.A + (size_t)nxt.pm * tstep : cA; const char* nB = has_next ? (const char*)g.Bt + (size_t)nxt.pn * tstep : cB;
        for (int t = 0; t < nt; t += 2) {
            const bool last = (t == nt - 2);
            const char* a1 = cA + (size_t)(t + 1) * kstep;
            const char* a2 = last ? nA : cA + (size_t)(t + 2) * kstep; const char* b2 = last ? nB : cB + (size_t)(t + 2) * kstep;
            const char* a3 = a2 + kstep; const char* b3 = b2 + kstep;
            if (last && has_next) S.a_ready(nxt);
            if constexpr (SP2) {
            PG8_LDB(B0, 0, 0); PG8_LDB(B1, 0, 1); PG8_SCHED; PG8_LDA(At, 0, 0); PG8_STAGE(PG8_SA(1, 1), a1 + hstep, voffA);
            PG8_WAIT_V(8); PG8_WAIT_L(0); PG8_BAR; PG8_MMA(0, 0, At, B0); PG8_MMA(0, 1, At, B1); PG8_BAR; PG8_SCHED;
            PG8_LDA(At, 0, 1); PG8_STAGE(PG8_SB(0, 0), b2, voffB); PG8_STAGE(PG8_SB(0, 1), b2 + hstep, voffB); PG8_STAGE(PG8_SA(0, 0), a2, voffA);
            PG8_WAIT_V(8); PG8_WAIT_L(0); PG8_BAR; PG8_MMA(1, 0, At, B0); PG8_MMA(1, 1, At, B1); PG8_BAR; PG8_SCHED;
            PG8_LDB(B0, 1, 0); PG8_LDB(B1, 1, 1); PG8_SCHED; PG8_LDA(At, 1, 0); PG8_STAGE(PG8_SA(0, 1), a2 + hstep, voffA);
            PG8_WAIT_V(8); PG8_WAIT_L(0); PG8_BAR; PG8_MMA(0, 0, At, B0); PG8_MMA(0, 1, At, B1); PG8_BAR; PG8_SCHED;
            PG8_LDA(At, 1, 1); PG8_STAGE(PG8_SB(1, 0), b3, voffB); PG8_STAGE(PG8_SB(1, 1), b3 + hstep, voffB); PG8_STAGE(PG8_SA(1, 0), a3, voffA);
            PG8_WAIT_V(8); PG8_WAIT_L(0); PG8_BAR; PG8_MMA(1, 0, At, B0); PG8_MMA(1, 1, At, B1); PG8_BAR; PG8_SCHED;
            } else {
            PG8_LDB(B0, 0, 0); PG8_SCHED; PG8_LDA(At, 0, 0); PG8_STAGE(PG8_SA(1, 1), a1 + hstep, voffA);
            PG8_WAIT_L(8); PG8_BAR; PG8_WAIT_L(0); PG8_MMA(0, 0, At, B0); PG8_BAR; PG8_SCHED;
            PG8_LDB(B1, 0, 1); PG8_STAGE(PG8_SB(0, 0), b2, voffB);
            PG8_BAR; PG8_WAIT_L(0); PG8_MMA(0, 1, At, B1); PG8_BAR;
            PG8_LDA(At, 0, 1); PG8_STAGE(PG8_SA(0, 0), a2, voffA);
            PG8_BAR; PG8_WAIT_L(0); PG8_MMA(1, 0, At, B0); PG8_BAR; PG8_SCHED;
            PG8_STAGE(PG8_SB(0, 1), b2 + hstep, voffB);
            PG8_WAIT_V(6); PG8_BAR; PG8_MMA(1, 1, At, B1); PG8_BAR;
            PG8_LDB(B0, 1, 0); PG8_SCHED; PG8_LDA(At, 1, 0); PG8_STAGE(PG8_SA(0, 1), a2 + hstep, voffA);
            PG8_WAIT_L(8); PG8_BAR; PG8_WAIT_L(0); PG8_MMA(0, 0, At, B0); PG8_BAR; PG8_SCHED;
            PG8_LDB(B1, 1, 1); PG8_STAGE(PG8_SB(1, 0), b3, voffB);
            PG8_BAR; PG8_WAIT_L(0); PG8_MMA(0, 1, At, B1); PG8_BAR;
            PG8_LDA(At, 1, 1); PG8_STAGE(PG8_SA(1, 0), a3, voffA);
            PG8_BAR; PG8_WAIT_L(0); PG8_MMA(1, 0, At, B0); PG8_BAR; PG8_SCHED;
            PG8_STAGE(PG8_SB(1, 1), b3 + hstep, voffB);
            PG8_WAIT_V(6); PG8_BAR; PG8_MMA(1, 1, At, B1); PG8_BAR;
            }
        }
        if constexpr (ALIGN_EPI) { if (wr == 0) PG8_BAR; }
#ifdef TPROBE
        unsigned long long te0 = 0; if (g.tp && threadIdx.x == 0) te0 = __builtin_amdgcn_s_memrealtime();
#endif
        if constexpr (!Epi::AFTER_DRAIN) { E(acc, cur, wr, wc, fr, fq); S.done(cur); }
#ifdef TPROBE
        if (g.tp && threadIdx.x == 0) atomicAdd(g.tp, __builtin_amdgcn_s_memrealtime() - te0);
#endif
        if (!has_next) break;
#pragma unroll
        for (int a = 0; a < 2; ++a)
#pragma unroll
            for (int b = 0; b < 2; ++b)
#pragma unroll
                for (int m = 0; m < 4; ++m)
#pragma unroll
                    for (int n = 0; n < 2; ++n) acc[a][b][m][n] = (f32x4){0.f, 0.f, 0.f, 0.f};
        cur = nxt; cA = nA; cB = nB; ++ui;
        if constexpr (ALIGN_EPI) { if (wr == 1) PG8_BAR; }
    }
    PG8_WAIT_V(0);
    if constexpr (!ALIGN_EPI) { if (wr == 0) PG8_BAR; }
    PG8_BAR;
    if constexpr (Epi::AFTER_DRAIN) { E.fused(acc, cur, wr, wc, fr, fq, lds, wid, lane); S.done(cur); }
#undef PG8_SA
#undef PG8_SB
#undef PG8_STAGE
#undef PG8_LDA
#undef PG8_LDB
#undef PG8_MMA
#undef PG8_WAIT_V
#undef PG8_WAIT_L
#undef PG8_BAR
#undef PG8_SCHED
}

struct EpiInProj {
    static constexpr bool PERM = true, AFTER_DRAIN = false;
    bf16_t* P; int ldp; float* SM; int last_pn;
    __device__ __forceinline__ void operator()(const f32x4 (&acc)[2][2][4][2], const Unit& u, int wr, int wc, int fr, int fq) const {
        const int row0 = u.pm * BM + wr * 64 + fr;
        if (u.pn == last_pn) {
            if (wc == 0) {
#pragma unroll
                for (int ai = 0; ai < 2; ++ai)
#pragma unroll
                    for (int m = 0; m < 4; ++m) { float* rp = SM + (size_t)(row0 + ai * HALF + m * 16) * 32 + 8 * fq;
                        *(f32x4*)(rp) = acc[ai][0][m][0]; *(f32x4*)(rp + 4) = acc[ai][0][m][1]; }
            }
            return;
        }
        const int col0 = u.pn * BM + wc * 32 + 8 * fq;
#pragma unroll
        for (int ai = 0; ai < 2; ++ai)
#pragma unroll
            for (int m = 0; m < 4; ++m) { bf16_t* rowp = P + (size_t)(row0 + ai * HALF + m * 16) * ldp + col0;
#pragma unroll
                for (int bj = 0; bj < 2; ++bj) { const f32x4 v0 = acc[ai][bj][m][0], v1 = acc[ai][bj][m][1];
                    u32x4 w; w.x = cvt_pk_bf16(v0[0], v0[1]); w.y = cvt_pk_bf16(v0[2], v0[3]); w.z = cvt_pk_bf16(v1[0], v1[1]); w.w = cvt_pk_bf16(v1[2], v1[3]);
                    *(u32x4*)(rowp + bj * HALF) = w; } }
    }
};
struct EpiOutProj {
    static constexpr bool PERM = true, AFTER_DRAIN = false;
    const float* srcC; const float* srcL; bf16_t* X; const float* gate;
    static __device__ __forceinline__ float lo(unsigned w) { return __builtin_bit_cast(float, w << 16); }
    static __device__ __forceinline__ float hi(unsigned w) { return __builtin_bit_cast(float, w & 0xffff0000u); }
    __device__ __forceinline__ void operator()(const f32x4 (&acc)[2][2][4][2], const Unit& u, int wr, int wc, int fr, int fq) const {
        const int row0 = u.pm * BM + wr * 64 + fr, col0 = u.pn * BM + wc * 32 + 8 * fq;
        const int cond = (u.pm < 16) ? 0 : 1 + ((u.pm - 16) >> 2);
        const float* gp = gate + (size_t)cond * 6144 + col0;
        f32x4 gv[2][2];
#pragma unroll
        for (int bj = 0; bj < 2; ++bj) { gv[bj][0] = *(const f32x4*)(gp + bj * HALF); gv[bj][1] = *(const f32x4*)(gp + bj * HALF + 4); }
        if (srcC != nullptr) {
            const float* sp = (u.pm < 16) ? srcC : (srcL - (size_t)4096 * 2048);
#pragma unroll
            for (int ai = 0; ai < 2; ++ai)
#pragma unroll
                for (int mp = 0; mp < 2; ++mp) { f32x4 xi[2][2][2];
#pragma unroll
                    for (int mm = 0; mm < 2; ++mm)
#pragma unroll
                        for (int bj = 0; bj < 2; ++bj) { const float* xp = sp + (size_t)(row0 + ai * HALF + (2 * mp + mm) * 16) * 2048 + col0 + bj * HALF; xi[mm][bj][0] = *(const f32x4*)xp; xi[mm][bj][1] = *(const f32x4*)(xp + 4); }
#pragma unroll
                    for (int mm = 0; mm < 2; ++mm)
#pragma unroll
                        for (int bj = 0; bj < 2; ++bj) { const int m = 2 * mp + mm; const f32x4 x0 = xi[mm][bj][0] + gv[bj][0] * acc[ai][bj][m][0], x1 = xi[mm][bj][1] + gv[bj][1] * acc[ai][bj][m][1];
                            u32x4 w; w.x = cvt_pk_bf16(x0[0], x0[1]); w.y = cvt_pk_bf16(x0[2], x0[3]); w.z = cvt_pk_bf16(x1[0], x1[1]); w.w = cvt_pk_bf16(x1[2], x1[3]);
                            *(u32x4*)(X + (size_t)(row0 + ai * HALF + m * 16) * 2048 + col0 + bj * HALF) = w; } }
        } else {
#pragma unroll
            for (int ai = 0; ai < 2; ++ai) { u32x4 t[4][2];
#pragma unroll
                for (int m = 0; m < 4; ++m)
#pragma unroll
                    for (int bj = 0; bj < 2; ++bj) t[m][bj] = *(const u32x4*)(X + (size_t)(row0 + ai * HALF + m * 16) * 2048 + col0 + bj * HALF);
#pragma unroll
                for (int m = 0; m < 4; ++m)
#pragma unroll
                    for (int bj = 0; bj < 2; ++bj) { const u32x4 tt = t[m][bj]; const f32x4 v0 = acc[ai][bj][m][0], v1 = acc[ai][bj][m][1], g0 = gv[bj][0], g1 = gv[bj][1];
                        u32x4 w; w.x = cvt_pk_bf16(lo(tt.x) + g0[0] * v0[0], hi(tt.x) + g0[1] * v0[1]); w.y = cvt_pk_bf16(lo(tt.y) + g0[2] * v0[2], hi(tt.y) + g0[3] * v0[3]);
                        w.z = cvt_pk_bf16(lo(tt.z) + g1[0] * v1[0], hi(tt.z) + g1[1] * v1[1]); w.w = cvt_pk_bf16(lo(tt.w) + g1[2] * v1[2], hi(tt.w) + g1[3] * v1[3]);
                        *(u32x4*)(X + (size_t)(row0 + ai * HALF + m * 16) * 2048 + col0 + bj * HALF) = w; } }
        }
    }
};
struct SubsetOrder : StaticOrder {
    int odd;
    __device__ __forceinline__ bool next(int i, Unit& u) const {
        if (!StaticOrder::next(i, u)) return false;
        const int p = u.pn; u.pn = odd ? (p < 8 ? p : (p < 20 ? p + 4 : p + 5)) : (p < 12 ? p : p + 3); return true; }
};
struct SingleOrder {
    int pm, pn;
    __device__ __forceinline__ bool next(int i, Unit& u) const { if (i != 0) return false; u.pm = pm; u.pn = pn; return true; }
    __device__ __forceinline__ void a_ready(const Unit&) const {}
    __device__ __forceinline__ void done(const Unit&) const {}
};
}

typedef unsigned short bf16;
typedef short bf16x8 __attribute__((ext_vector_type(8)));
typedef float f32x4 __attribute__((ext_vector_type(4)));
typedef unsigned u32x4 __attribute__((ext_vector_type(4)));
typedef unsigned u32x2 __attribute__((ext_vector_type(2)));
#define LAS __attribute__((address_space(3)))

constexpr int DM = 2048, MCTX = 4096, MROWS = 8192;
constexpr int NP_E = 6912, LDP_E = 6656, NP_O = 7424, LDP_O = 7168;
constexpr int E_QA = 0, E_KA = 1024, E_VA = 2048, E_ZA = 3072, E_QB = 4096, E_KB = 5120, E_VB = 5376, E_ZB = 5632;
constexpr int O_QC = 0, O_KC = 512, O_VC = 1024, O_ZC = 2048, O_QD = 3072, O_KD = 4096, O_VD = 5120, O_ZD = 6144;
constexpr float EPSF = 1e-6f;
constexpr float ATT_SCALE = 0.08838834764831845f;
constexpr int NWAVES = 8, NTHREADS = 512;

constexpr size_t MiB = 1u << 20;
constexpr size_t WS_CTL = 0, CTL_ZERO_BYTES = 1 * MiB;
constexpr size_t WS_MOD = 1 * MiB;
constexpr size_t WS_WIN_E = 2 * MiB, WIN_E_BYTES = (size_t)NP_E * DM * 2;
constexpr size_t WS_WIN_O = 56 * MiB, WIN_O_BYTES = (size_t)NP_O * DM * 2;
constexpr size_t WS_WOUT = 114 * MiB, WOUT_BYTES = (size_t)DM * DM * 2;
constexpr size_t WS_X = 146 * MiB;
constexpr size_t WS_H = 210 * MiB;
constexpr size_t WS_OMIX = 242 * MiB;
constexpr size_t WS_P = 274 * MiB;
constexpr size_t WS_SM = 386 * MiB;
constexpr size_t WS_OF = 388 * MiB, WS_OB = 420 * MiB;
constexpr size_t WS_QR = 452 * MiB, WS_KR = 460 * MiB;
constexpr size_t WS_PREP = 462 * MiB;
constexpr size_t WS_DW = WS_PREP, WS_DU = WS_DW + 112 * MiB, WS_DG = WS_DU + 64 * MiB;
constexpr size_t WS_GO = WS_PREP, WS_GV = WS_GO + 42 * MiB;
constexpr size_t WS_TCACHE_E = WS_DG + 1 * MiB;
constexpr size_t WS_TCACHE_O = WS_TCACHE_E + 2 * MiB;
constexpr size_t WS_TCTX = WS_TCACHE_O + 8 * MiB;
constexpr size_t WS_TLAT = WS_TCTX + 16 * MiB;
constexpr size_t WS_ROPE = WS_TLAT + 16 * MiB;
constexpr size_t WS_END = WS_ROPE + 1 * MiB;
static_assert(WS_WIN_E + 2 * WIN_E_BYTES <= WS_WIN_O && WS_WIN_O + 2 * WIN_O_BYTES <= WS_WOUT && WS_WOUT + 4 * WOUT_BYTES <= WS_X, "ws map");
static_assert(WS_GV + 16 * MiB <= WS_END, "ws map");

constexpr int LDS_BYTES = 147456;
constexpr int LDS_MISC = 144 * 1024 - 256;

constexpr size_t OUT_Y = 0, OUT_SD = 16777216, OUT_KVW = 25165824, OUT_SG = 29360128, OUT_KVN = 37748736, OUT_TOTAL = 54525952;

struct Args {
    const float* in[25];
    float* out; unsigned char* ws;
    int ph_lo, ph_hi, coop, pad;
};

struct Frame {
    LAS unsigned char* lds;
    unsigned char* smem;
    int tid, G, bid;
    const float* const* in;
    float* out; unsigned char* ws;
};


#define FRESH_IDS() int tid = F.tid; asm volatile("" : "+v"(tid)); const int lane = tid & 63; const int wave = __builtin_amdgcn_readfirstlane(tid >> 6); (void)lane; (void)wave;
#ifdef TPROBE
#ifdef TPCOUNT
#define TP_VAL(x) 1ull
#else
#define TP_VAL(x) (x)
#endif
#define TP_BEGIN(n) unsigned long long tp_t0_##n = 0; if (TPROBE == (n) && (blockIdx.x == 0 || (n) >= 10) && threadIdx.x == 0) tp_t0_##n = __builtin_amdgcn_s_memrealtime();
#define TP_END(n) if (TPROBE == (n) && (blockIdx.x == 0 || (n) >= 10) && threadIdx.x == 0) { unsigned long long* tp_ = (unsigned long long*)(F.ws + WS_CTL + 768 * 1024); atomicAdd(tp_, (unsigned long long)TP_VAL(__builtin_amdgcn_s_memrealtime() - tp_t0_##n)); }
#else
#define TP_BEGIN(n)
#define TP_END(n)
#endif
__device__ __forceinline__ float bf2f(unsigned h) { return __builtin_bit_cast(float, h << 16); }
typedef float f32x2_t __attribute__((ext_vector_type(2))); typedef __bf16 bf16x2_t __attribute__((ext_vector_type(2)));
__device__ __forceinline__ unsigned pk2(float lo, float hi) { f32x2_t v = {lo, hi}; bf16x2_t b = __builtin_convertvector(v, bf16x2_t); return __builtin_bit_cast(unsigned, b); }
__device__ __forceinline__ unsigned f2bf(float f) { return pk2(f, 0.f) & 0xffffu; }
template <int CTRL> __device__ __forceinline__ float dpp_mov(float v) { return __builtin_bit_cast(float, __builtin_amdgcn_update_dpp(0, __builtin_bit_cast(int, v), CTRL, 0xf, 0xf, false)); }
template <int MASK> __device__ __forceinline__ void xswap(float v, float& r0, float& r1) {
    unsigned a = __builtin_bit_cast(unsigned, v), b = a;
    if constexpr (MASK == 16) asm volatile("s_nop 1\n\tv_permlane16_swap_b32 %0, %1" : "+v"(a), "+v"(b));
    else asm volatile("s_nop 1\n\tv_permlane32_swap_b32 %0, %1" : "+v"(a), "+v"(b));
    r0 = __builtin_bit_cast(float, a); r1 = __builtin_bit_cast(float, b);
}
template <int MASK> __device__ __forceinline__ float xsum(float v) {
    if constexpr (MASK == 1) return v + dpp_mov<0xB1>(v);
    else if constexpr (MASK == 2) return v + dpp_mov<0x4E>(v);
    else if constexpr (MASK == 4) return v + dpp_mov<0x141>(v);
    else if constexpr (MASK == 8) return v + dpp_mov<0x140>(v);
    else { float r0, r1; xswap<MASK>(v, r0, r1); return r0 + r1; }
}
template <int MASK> __device__ __forceinline__ float xmax(float v) { float r0, r1; xswap<MASK>(v, r0, r1); return fmaxf(r0, r1); }
__device__ __forceinline__ float wave_sum(float v) { v = xsum<1>(v); v = xsum<2>(v); v = xsum<4>(v); v = xsum<8>(v); v = xsum<16>(v); return xsum<32>(v); }
__device__ __forceinline__ float siluf(float v) { return v * __builtin_amdgcn_rcpf(1.f + __expf(-v)); }
__device__ __forceinline__ float sigmoidf_(float v) { return __builtin_amdgcn_rcpf(1.f + __expf(-v)); }
__device__ __forceinline__ float softplusf_(float v) { return fmaxf(v, 0.f) + __logf(1.f + __expf(-fabsf(v))); }
__device__ __forceinline__ float logsigmoidf_(float v) { return fminf(v, 0.f) - __logf(1.f + __expf(-fabsf(v))); }
__device__ __forceinline__ int kinv32(int e) { return 8 * ((e >> 2) & 3) + 4 * (e >> 4) + (e & 3); }
__device__ __forceinline__ f32x4 mfma16(bf16x8 a, bf16x8 b, f32x4 c) { return __builtin_amdgcn_mfma_f32_16x16x32_bf16(a, b, c, 0, 0, 0); }
__device__ __forceinline__ bf16x8 pack_acc(f32x4 lo, f32x4 hi) {
    u32x4 w; w.x = pk2(lo[0], lo[1]); w.y = pk2(lo[2], lo[3]); w.z = pk2(hi[0], hi[1]); w.w = pk2(hi[2], hi[3]);
    return __builtin_bit_cast(bf16x8, w);
}
__device__ __forceinline__ bf16x8 ld8(const bf16* p) { return *(const bf16x8*)p; }
__device__ __forceinline__ bf16x8 ld8_f32(const float* p) {
    const f32x4 a = *(const f32x4*)p, b = *(const f32x4*)(p + 4);
    u32x4 w; w.x = pk2(a[0], a[1]); w.y = pk2(a[2], a[3]); w.z = pk2(b[0], b[1]); w.w = pk2(b[2], b[3]);
    return __builtin_bit_cast(bf16x8, w);
}
__device__ __forceinline__ void seq_of_row(int m, int& s0, int& L) { if (m < MCTX) { s0 = m & ~255; L = 256; } else { s0 = MCTX + ((m - MCTX) & ~1023); L = 1024; } }
__device__ __forceinline__ int cond_of_row(int m) { return (m < MCTX) ? 0 : 1 + ((m - MCTX) >> 10); }

struct TItem { const float* W; bf16* WT; int N, k0, n0, drow0; };
__device__ __forceinline__ void transpose_load(const TItem& t, f32x4 (&v)[8], int lane) {
    const int r8 = lane >> 3, c4 = lane & 7;
#pragma unroll
    for (int i = 0; i < 8; ++i) v[i] = *(const f32x4*)(t.W + (size_t)(t.k0 + 8 * i + r8) * t.N + t.n0 + 4 * c4);
}
__device__ __forceinline__ void transpose_store(const TItem& t, const f32x4 (&v)[8], float* scr, int lane) {
    const int r8 = lane >> 3, c4 = lane & 7;
#pragma unroll
    for (int i = 0; i < 8; ++i) { float* s = scr + (8 * i + r8) * 33 + 4 * c4; s[0] = v[i][0]; s[1] = v[i][1]; s[2] = v[i][2]; s[3] = v[i][3]; }
    asm volatile("s_waitcnt lgkmcnt(0)" ::: "memory");
    const int c = lane & 7;
#pragma unroll
    for (int j = 0; j < 4; ++j) { const int n = (lane >> 3) + 8 * j; const float* s = scr + (8 * c) * 33 + n;
        u32x4 o; o.x = pk2(s[0 * 33], s[1 * 33]); o.y = pk2(s[2 * 33], s[3 * 33]); o.z = pk2(s[4 * 33], s[5 * 33]); o.w = pk2(s[6 * 33], s[7 * 33]);
        *(u32x4*)(t.WT + (size_t)(t.drow0 + n) * DM + t.k0 + 8 * c) = o; }
    asm volatile("s_waitcnt lgkmcnt(0)" ::: "memory");
}
__device__ __forceinline__ int remap_even(int n0) { return n0 < 4096 ? n0 : (n0 < 4128 ? n0 + 2560 : n0 - 32); }
__device__ __forceinline__ int remap_odd(int n0) { return n0 < 3072 ? n0 : (n0 < 3104 ? n0 + 4096 : n0 - 32); }

__device__ __forceinline__ void phase_prologue(Frame& F) {
    FRESH_IDS();
    float* scr = (float*)(F.smem + wave * 16384);
    const int gw = F.bid * NWAVES + wave, NGW = F.G * NWAVES;
    constexpr int I_E = 32 * 209, I_O = 32 * 225, I_W = 32 * 64;
    constexpr int NITEMS = 2 * I_E + 2 * I_O + 4 * I_W;
    auto item = [&](int it) -> TItem { int r = it; TItem t;
        if (r < 2 * I_E) { const int e = r / I_E; r -= e * I_E; const int kb = r / 209, nb = r % 209;
            t.W = F.in[11] + (size_t)e * DM * 6688; t.N = 6688; t.WT = (bf16*)(F.ws + WS_WIN_E + e * WIN_E_BYTES); t.k0 = 64 * kb; t.n0 = 32 * nb; t.drow0 = remap_even(32 * nb); return t; }
        r -= 2 * I_E;
        if (r < 2 * I_O) { const int e = r / I_O; r -= e * I_O; const int kb = r / 225, nb = r % 225;
            t.W = F.in[18] + (size_t)e * DM * 7200; t.N = 7200; t.WT = (bf16*)(F.ws + WS_WIN_O + e * WIN_O_BYTES); t.k0 = 64 * kb; t.n0 = 32 * nb; t.drow0 = remap_odd(32 * nb); return t; }
        r -= 2 * I_O;
        const int li = r / I_W; r -= li * I_W; const int kb = r / 64, nb = r % 64;
        t.W = (li & 1) ? F.in[23] + (size_t)(li >> 1) * DM * DM : F.in[17] + (size_t)(li >> 1) * DM * DM; t.N = DM; t.WT = (bf16*)(F.ws + WS_WOUT + li * WOUT_BYTES); t.k0 = 64 * kb; t.n0 = 32 * nb; t.drow0 = 32 * nb; return t; };
    if (gw < NITEMS) {
        TItem tc = item(gw); f32x4 vc[8]; transpose_load(tc, vc, lane);
        for (int it = gw; it < NITEMS; it += NGW) {
            const bool more = it + NGW < NITEMS; const TItem tn = item(more ? it + NGW : it); f32x4 vn[8];
            transpose_load(tn, vn, lane);
            transpose_store(tc, vc, scr, lane);
            tc = tn;
#pragma unroll
            for (int i = 0; i < 8; ++i) vc[i] = vn[i];
        }
    }
    __syncthreads();
    float* scv = (float*)F.smem;
    float* red = (float*)(F.smem + 65536);
    for (int k = tid; k < DM; k += NTHREADS) {
#pragma unroll
        for (int cd = 0; cd < 5; ++cd) { const float v = (cd == 0) ? F.in[7][k] : F.in[6][(cd - 1) * DM + k]; scv[k * 8 + cd] = siluf(v); }
    }
    __syncthreads();
    float* MOD = (float*)(F.ws + WS_MOD);
    for (int unit = F.bid; unit < 768; unit += F.G) {
        const int li = unit / 192, cb = unit % 192, kr = lane >> 3, col = cb * 32 + 4 * (lane & 7);
        f32x4 acc[5];
#pragma unroll
        for (int cd = 0; cd < 5; ++cd) acc[cd] = (f32x4){0.f, 0.f, 0.f, 0.f};
        const float* wp = F.in[9] + ((size_t)li * DM + wave * 256 + kr) * 6144 + col;
#pragma unroll 8
        for (int it = 0; it < 32; ++it) {
            const f32x4 w = *(const f32x4*)(wp + (size_t)it * 8 * 6144);
            const float* sp = scv + (wave * 256 + it * 8 + kr) * 8;
            const f32x4 s4 = *(const f32x4*)sp; const float s5 = sp[4];
            acc[0] += w * s4[0]; acc[1] += w * s4[1]; acc[2] += w * s4[2]; acc[3] += w * s4[3]; acc[4] += w * s5;
        }
#pragma unroll
        for (int cd = 0; cd < 5; ++cd)
#pragma unroll
            for (int q = 0; q < 4; ++q) { float v = acc[cd][q]; v += __shfl_xor(v, 8); v = xsum<16>(v); v = xsum<32>(v); acc[cd][q] = v; }
        if (lane < 8) {
#pragma unroll
            for (int cd = 0; cd < 5; ++cd) *(f32x4*)(red + (wave * 5 + cd) * 64 + 4 * lane) = acc[cd];
        }
        __syncthreads();
        if (tid < 160) { const int cd = tid >> 5, cc = tid & 31; float s = F.in[10][(size_t)li * 6144 + cb * 32 + cc];
#pragma unroll
            for (int w = 0; w < 8; ++w) s += red[(w * 5 + cd) * 64 + cc];
            MOD[(size_t)(li * 5 + cd) * 6144 + cb * 32 + cc] = s; }
        __syncthreads();
    }
}

__device__ __forceinline__ void xrow_load(Frame& F, int li, int row, int lane, f32x4 (&v)[8]) {
    if (li == 0) { const f32x4* xr = (const f32x4*)((row < MCTX) ? F.in[0] + (size_t)row * DM : F.in[1] + (size_t)(row - MCTX) * DM) + lane;
#pragma unroll
        for (int j = 0; j < 8; ++j) v[j] = xr[64 * j]; }
    else { const u32x2* xr = (const u32x2*)(F.ws + WS_X) + (size_t)row * (DM / 4) + lane; u32x2 t[8];
#pragma unroll
        for (int j = 0; j < 8; ++j) t[j] = xr[64 * j];
#pragma unroll
        for (int j = 0; j < 8; ++j) v[j] = (f32x4){__builtin_bit_cast(float, t[j].x << 16), __builtin_bit_cast(float, t[j].x & 0xffff0000u), __builtin_bit_cast(float, t[j].y << 16), __builtin_bit_cast(float, t[j].y & 0xffff0000u)}; }
}
__device__ __forceinline__ void phase_norm(Frame& F, int li) {
    FRESH_IDS();
    const int gw = F.bid * NWAVES + wave, NGW = F.G * NWAVES;
    const float* MOD = (const float*)(F.ws + WS_MOD);
    bf16* H = (bf16*)(F.ws + WS_H);
    for (int grp = gw; grp < MROWS / 4; grp += NGW) {
        const int row0 = 4 * grp;
        f32x4 v[4][8]; float s[4];
#pragma unroll
        for (int q = 0; q < 4; ++q) xrow_load(F, li, row0 + q, lane, v[q]);
        const f32x4* nwp = (const f32x4*)(F.in[8] + (size_t)li * DM) + lane;
        const f32x4* mod = (const f32x4*)(MOD + (size_t)(li * 5 + cond_of_row(row0)) * 6144) + lane;
        f32x4 mw[3][3];
#pragma unroll
        for (int j = 0; j < 2; ++j) { mw[j][0] = nwp[64 * j]; mw[j][1] = mod[64 * j]; mw[j][2] = mod[DM / 4 + 64 * j]; }
#pragma unroll
        for (int q = 0; q < 4; ++q) { s[q] = 0.f;
#pragma unroll
            for (int j = 0; j < 8; ++j) s[q] += (v[q][j][0] * v[q][j][0] + v[q][j][1] * v[q][j][1]) + (v[q][j][2] * v[q][j][2] + v[q][j][3] * v[q][j][3]); }
#pragma unroll
        for (int q = 0; q < 4; ++q) s[q] = rsqrtf(wave_sum(s[q]) * (1.f / DM) + EPSF);
#pragma unroll
        for (int j = 0; j < 8; ++j) {
            if (j + 2 < 8) { mw[(j + 2) % 3][0] = nwp[64 * (j + 2)]; mw[(j + 2) % 3][1] = mod[64 * (j + 2)]; mw[(j + 2) % 3][2] = mod[DM / 4 + 64 * (j + 2)]; }
            const f32x4 wb = mw[j % 3][0] * (mw[j % 3][2] + 1.f), a = mw[j % 3][1];
#pragma unroll
            for (int q = 0; q < 4; ++q) { const f32x4 h = v[q][j] * s[q] * wb + a;
                u32x2 p; p.x = pk2(h[0], h[1]); p.y = pk2(h[2], h[3]); ((u32x2*)(H + (size_t)(row0 + q) * DM) + lane)[64 * j] = p; }
        }
    }
}
__device__ __forceinline__ void phase_final_norm(Frame& F) {
    FRESH_IDS();
    const int gw = F.bid * NWAVES + wave, NGW = F.G * NWAVES;
    for (int rowb = gw; rowb < MROWS; rowb += 4 * NGW) {
        int rows[4]; f32x4 v[4][8]; float s[4];
#pragma unroll
        for (int q = 0; q < 4; ++q) { rows[q] = (rowb + q * NGW < MROWS) ? rowb + q * NGW : rowb; xrow_load(F, 1, rows[q], lane, v[q]); }
        const f32x4* nwp = (const f32x4*)F.in[24] + lane;
        f32x4 w[8];
#pragma unroll
        for (int j = 0; j < 8; ++j) w[j] = nwp[64 * j];
#pragma unroll
        for (int q = 0; q < 4; ++q) { s[q] = 0.f;
#pragma unroll
            for (int j = 0; j < 8; ++j) s[q] += (v[q][j][0] * v[q][j][0] + v[q][j][1] * v[q][j][1]) + (v[q][j][2] * v[q][j][2] + v[q][j][3] * v[q][j][3]); }
#pragma unroll
        for (int q = 0; q < 4; ++q) s[q] = wave_sum(s[q]);
#pragma unroll
        for (int q = 0; q < 4; ++q) { if (q > 0 && rows[q] == rowb) continue;
            const float rstd = rsqrtf(s[q] * (1.f / DM) + EPSF);
            f32x4* o = (f32x4*)(F.out + OUT_Y) + (size_t)rows[q] * (DM / 4) + lane;
#pragma unroll
            for (int j = 0; j < 8; ++j) o[64 * j] = v[q][j] * rstd * w[j]
#ifdef TPROBE
                + TPK * (float)(*(const unsigned long long*)(F.ws + WS_CTL + 768 * 1024))
#endif
                ; }
    }
}

constexpr int QSTR = 136;
constexpr int TSTR = 72;
constexpr int OPS_BYTES = 57344, OPS_W = 0, OPS_Q = 16384, OPS_K = 32768, OPS_A = 49152;
constexpr int DP_QS = 0, DP_KS = 17408, DP_KT = 34816, DP_VT = 53248, DP_LM = 71680, DP_TI = 104448, DP_SC = 122880, DP_CW = 126976;
static_assert(DP_SC + 4096 <= DP_CW && DP_CW + 7680 <= LDS_MISC, "delta prep LDS");

__device__ __forceinline__ bf16x8 scale8(bf16x8 v, const float (&s)[8]) {
    u32x4 w;
#pragma unroll
    for (int p = 0; p < 4; ++p) w[p] = pk2(bf2f((unsigned short)v[2 * p]) * s[2 * p], bf2f((unsigned short)v[2 * p + 1]) * s[2 * p + 1]);
    return __builtin_bit_cast(bf16x8, w);
}
__device__ __forceinline__ bf16x8 ld44(const bf16* p0, const bf16* p1) {
    const u32x2 a = *(const u32x2*)p0, b = *(const u32x2*)p1; u32x4 w; w.x = a.x; w.y = a.y; w.z = b.x; w.w = b.y; return __builtin_bit_cast(bf16x8, w);
}

struct ConvIn { unsigned xr[3][12]; float rb, rg, al, dtb; };
__device__ __forceinline__ void delta_conv_load(Frame& F, ConvIn& C, int e, int tc, int h, int tid) {
    const int lane = tid & 63, wave = __builtin_amdgcn_readfirstlane(tid >> 6), ch = 2 * lane;
    const int m0 = tc * 64; int s0, L; seq_of_row(m0, s0, L); const int t0 = m0 - s0;
    const bf16* P = (const bf16*)(F.ws + WS_P); const float* SM = (const float*)(F.ws + WS_SM);
#pragma unroll
    for (int T = 0; T < 3; ++T) { const int col = T * 1024 + h * 128 + ch;
#pragma unroll
        for (int r = 0; r < 12; ++r) { const int t = t0 + 8 * wave - 2 + r, tcl = t < 0 ? 0 : (t >= L ? L - 1 : t);
            C.xr[T][r] = *(const unsigned*)(P + (size_t)(s0 + tcl) * LDP_E + col); } }
    C.rb = 0.f; C.rg = 0.f; C.al = 0.f; C.dtb = 0.f;
    if (tid < 128) { const float* sm = SM + (size_t)(m0 + (tid & 63)) * 32; C.rb = sm[8 * (tid >> 6) + h]; C.rg = sm[16 + 8 * (tid >> 6) + h];
        C.al = F.in[13][(e * 2 + (tid >> 6)) * 8 + h]; C.dtb = F.in[14][(e * 2 + (tid >> 6)) * 8 + h]; }
}
__device__ __forceinline__ void delta_conv_zero(ConvIn& C) {
#pragma unroll
    for (int T = 0; T < 3; ++T)
#pragma unroll
        for (int r = 0; r < 12; ++r) C.xr[T][r] = 0u;
    C.rb = 0.f; C.rg = 0.f; C.al = 0.f; C.dtb = 0.f;
}
__device__ __forceinline__ void delta_conv_weights(Frame& F, int e, int h, int tid) {
    float* CW = (float*)(F.smem + DP_CW);
    for (int idx = tid; idx < 15 * 128; idx += NTHREADS) { const int tj = idx >> 7, chn = idx & 127, T = tj / 5, j = tj - 5 * T;
        CW[idx] = F.in[12][((size_t)e * 5 + j) * 3072 + T * 1024 + h * 128 + chn]; }
}
__device__ __forceinline__ void delta_prep_unit(Frame& F, int e, int tc, int h, ConvIn& C, int tc_next) {
    FRESH_IDS();
    TP_BEGIN(1)
    bf16* Qs = (bf16*)(F.smem + DP_QS); bf16* Ks = (bf16*)(F.smem + DP_KS); bf16* Kt = (bf16*)(F.smem + DP_KT); bf16* Vt = (bf16*)(F.smem + DP_VT);
    float* Lm = (float*)(F.smem + DP_LM); bf16* Ti = (bf16*)(F.smem + DP_TI);
    float* sBeta = (float*)(F.smem + DP_SC);
    float* sG = sBeta + 128;
    float* sGc = sG + 128;
    float* sEg = sGc + 128;
    float* sBe = sEg + 128;
    float* sEd = sBe + 128;
    const int m0 = tc * 64; int s0, L; seq_of_row(m0, s0, L); const int t0 = m0 - s0;
    const bf16* P = (const bf16*)(F.ws + WS_P);
    const float* SM = (const float*)(F.ws + WS_SM);
    const int c = lane & 15, g = lane >> 4;
    const float rb_pre = C.rb, rg_pre = C.rg, al_pre = C.al, dtb_pre = C.dtb;
    __syncthreads();
#ifndef REP_CONV
#define REP_CONV 1
#endif
#ifndef REP_INV
#define REP_INV 1
#endif
#ifndef REP_WU
#define REP_WU 1
#endif
#ifndef REP_G
#define REP_G 1
#endif
    TP_BEGIN(5)
#pragma unroll 1
    for (int rep_ = 0; rep_ < REP_CONV; ++rep_) {
        const int ch = 2 * lane;
#pragma unroll
        for (int T = 0; T < 3; ++T) {
            float x0[12], x1[12]; f32x2_t cw[5];
#pragma unroll
            for (int j = 0; j < 5; ++j) cw[j] = *(const f32x2_t*)((const float*)(F.smem + DP_CW) + (T * 5 + j) * 128 + ch);
#pragma unroll
            for (int r = 0; r < 12; ++r) { const unsigned xw = ((unsigned)(t0 + 8 * wave - 2 + r) < (unsigned)L) ? C.xr[T][r] : 0u;
                x0[r] = bf2f(xw & 0xffffu); x1[r] = bf2f(xw >> 16); }
            float y0[8], y1[8], ss[8];
#pragma unroll
            for (int i = 0; i < 8; ++i) { float a0 = 0.f, a1 = 0.f;
#pragma unroll
                for (int j = 0; j < 5; ++j) { a0 += cw[j][0] * x0[i + j]; a1 += cw[j][1] * x1[i + j]; }
                y0[i] = siluf(a0); y1[i] = siluf(a1); ss[i] = y0[i] * y0[i] + y1[i] * y1[i]; }
            if (T < 2) {
#pragma unroll
                for (int i = 0; i < 8; ++i) ss[i] = wave_sum(ss[i]);
#pragma unroll
                for (int i = 0; i < 8; ++i) { float rn = rsqrtf(ss[i] + EPSF); if (T == 0) rn *= ATT_SCALE; y0[i] *= rn; y1[i] *= rn; }
            }
            if (T < 2) {
#pragma unroll
                for (int i = 0; i < 8; ++i) *(unsigned*)((T == 0 ? Qs : Ks) + (8 * wave + i) * QSTR + ch) = pk2(y0[i], y1[i]);
            }
            if (T >= 1) {
                u32x4 t0, t1;
#pragma unroll
                for (int p = 0; p < 4; ++p) { t0[p] = pk2(y0[2 * p], y0[2 * p + 1]); t1[p] = pk2(y1[2 * p], y1[2 * p + 1]); }
                bf16* Tt = (T == 1) ? Kt : Vt;
                *(u32x4*)(Tt + ch * TSTR + 8 * wave) = t0; *(u32x4*)(Tt + (ch + 1) * TSTR + 8 * wave) = t1;
            }
        }
    }
    TP_END(5)
    TP_BEGIN(6)
#ifndef REP_BETA
#define REP_BETA 1
#endif
#ifndef REP_ST
#define REP_ST 1
#endif
#pragma unroll 1
    for (int rep2_ = 0; rep2_ < REP_BETA; ++rep2_) {
    if (tid < 128) { const int d = tid >> 6; const float rb = rb_pre, rg = rg_pre;
        sBeta[tid] = sigmoidf_(rb);
        sG[tid] = -__expf(al_pre) * softplusf_(rg + dtb_pre); }
    __syncthreads();
    if (wave < 2) { const int d = wave, i = lane; float s = 0.f, tot = 0.f;
        f32x4 gv[16];
#pragma unroll
        for (int j4 = 0; j4 < 16; ++j4) gv[j4] = *(const f32x4*)(sG + d * 64 + 4 * j4);
        if (d == 0) {
#pragma unroll
            for (int j = 0; j < 64; ++j) { const float gg = gv[j >> 2][j & 3]; tot += gg; s += (j <= i) ? gg : 0.f; }
        } else {
#pragma unroll
            for (int j = 0; j < 64; ++j) { const float gg = gv[j >> 2][j & 3]; tot += gg; s += (j >= i) ? gg : 0.f; }
        }
        sGc[tid] = s; const float eg = __expf(s); sEg[tid] = eg; sBe[tid] = sBeta[tid] * eg; sEd[tid] = __expf(tot - s); }
    __syncthreads();
    }
    TP_END(6)
    TP_BEGIN(7)
#pragma unroll 1
    for (int rep_ = 0; rep_ < REP_G; ++rep_)
#pragma unroll
    for (int q = 0; q < 2; ++q) { const int t = wave * 2 + q, ti = t >> 2, tj = t & 3;
        const bf16* A = Ks + (16 * ti + c) * QSTR + 8 * g; const bf16* B = Ks + (16 * tj + c) * QSTR + 8 * g;
        f32x4 acc = {0.f, 0.f, 0.f, 0.f};
#pragma unroll
        for (int kk = 0; kk < 4; ++kk) acc = mfma16(ld8(A + 32 * kk), ld8(B + 32 * kk), acc);
        const int j = 16 * tj + c;
        const float gj0 = sGc[j], gj1 = sGc[64 + j];
        const f32x4 b0 = *(const f32x4*)(sBeta + 16 * ti + 4 * g), b1 = *(const f32x4*)(sBeta + 64 + 16 * ti + 4 * g), gi0 = *(const f32x4*)(sGc + 16 * ti + 4 * g), gi1 = *(const f32x4*)(sGc + 64 + 16 * ti + 4 * g);
#pragma unroll
        for (int r = 0; r < 4; ++r) { const int i = 16 * ti + 4 * g + r;
            float v0 = b0[r] * acc[r] * __expf(gi0[r] - gj0), v1 = b1[r] * acc[r] * __expf(gi1[r] - gj1);
            asm volatile("" : "+v"(v0), "+v"(v1));
            Lm[i * 64 + j] = (j < i) ? v0 : 0.f;
            Lm[4096 + (63 - i) * 64 + (63 - j)] = (j > i) ? v1 : 0.f; }
    }
    __syncthreads();
    TP_END(7)
    { TP_BEGIN(2)
#pragma unroll 1
    for (int rep_ = 0; rep_ < REP_INV; ++rep_)
    if (wave < 2) {
        const float* Lp = Lm + wave * 4096;
        f32x2_t x2[32];
#pragma unroll
        for (int p = 0; p < 32; ++p) x2[p] = (f32x2_t){0.f, 0.f};
        x2[0][0] = (lane == 0) ? 1.f : 0.f;
        f32x4 cur[16], nxt[11];
#pragma unroll
        for (int j4 = 0; j4 < 16; ++j4) cur[j4] = (f32x4){0.f, 0.f, 0.f, 0.f};
#pragma unroll
        for (int j4 = 0; j4 < 11; ++j4) nxt[j4] = (f32x4){0.f, 0.f, 0.f, 0.f};
        cur[0] = *(const f32x4*)(Lp + 64);
#pragma unroll
        for (int i = 1; i < 64; ++i) {
            if (i + 1 < 64) {
#pragma unroll
                for (int j4 = 0; j4 < (i + 4) / 4 && j4 < 11; ++j4) nxt[j4] = *(const f32x4*)(Lp + (i + 1) * 64 + 4 * j4);
            }
#pragma unroll
            for (int j4 = 11; j4 <= (i - 1) / 4; ++j4) cur[j4] = *(const f32x4*)(Lp + i * 64 + 4 * j4);
            f32x2_t a[2] = {{(lane == i) ? 1.f : 0.f, 0.f}, {0.f, 0.f}};
#pragma unroll
            for (int p = 0; p <= (i - 1) / 2; ++p) { const f32x2_t l2 = {cur[p >> 1][2 * (p & 1)], cur[p >> 1][2 * (p & 1) + 1]}; a[p & 1] = a[p & 1] - l2 * x2[p]; }
            const f32x2_t s = a[0] + a[1];
            x2[i >> 1][i & 1] = s[0] + s[1];
#pragma unroll
            for (int j4 = 0; j4 < 11; ++j4) cur[j4] = nxt[j4];
            if (i & 1) asm volatile("" : "+v"(x2[i >> 1]));
        }
#pragma unroll
        for (int i = 0; i < 64; ++i) { const int ri = wave ? 63 - i : i, rc = wave ? 63 - lane : lane; Ti[wave * 64 * TSTR + ri * TSTR + rc] = (bf16)f2bf(x2[i >> 1][i & 1]); }
    } else {
#pragma unroll 1
        for (int f = wave - 2; f < 64; f += 6) {
            const int d = f >> 5, isK = (f >> 4) & 1, fi = f & 15, unit = (tc * 8 + h) * 2 + d;
            bf16x8 o;
            if (!isK) { const int mb = fi >> 2, kk = fi & 3, i = 16 * mb + c; const float sc = sEg[d * 64 + i];
                const bf16x8 v = ld44(Qs + i * QSTR + 32 * kk + 4 * g, Qs + i * QSTR + 32 * kk + 16 + 4 * g);
                const float s8[8] = {sc, sc, sc, sc, sc, sc, sc, sc}; o = scale8(v, s8);
            } else { const int mb = fi >> 1, kk = fi & 1, dk = 16 * mb + c;
                const bf16x8 v = ld44(Kt + dk * TSTR + 32 * kk + 4 * g, Kt + dk * TSTR + 32 * kk + 16 + 4 * g);
                const f32x4 s0v = *(const f32x4*)(sEd + d * 64 + 32 * kk + 4 * g), s1v = *(const f32x4*)(sEd + d * 64 + 32 * kk + 16 + 4 * g);
                const float s8[8] = {s0v[0], s0v[1], s0v[2], s0v[3], s1v[0], s1v[1], s1v[2], s1v[3]}; o = scale8(v, s8); }
            *(bf16x8*)(F.ws + WS_DW + (size_t)unit * OPS_BYTES + (isK ? OPS_K : OPS_Q) + fi * 1024 + lane * 16) = o;
        }
#pragma unroll 1
        for (int t3 = wave - 2; t3 < 8; t3 += 6) {
            const int ib = t3 >> 1, kk2 = t3 & 1, i = 16 * ib + c;
            f32x4 st[2];
#pragma unroll
            for (int hf = 0; hf < 2; ++hf) { const bf16* A = Ks + (16 * (2 * kk2 + hf) + c) * QSTR + 8 * g; const bf16* B = Qs + (16 * ib + c) * QSTR + 8 * g;
                st[hf] = (f32x4){0.f, 0.f, 0.f, 0.f};
#pragma unroll
                for (int kk = 0; kk < 4; ++kk) st[hf] = mfma16(ld8(A + 32 * kk), ld8(B + 32 * kk), st[hf]); }
#pragma unroll
            for (int d = 0; d < 2; ++d) { f32x4 p[2]; const float gi = sGc[d * 64 + i];
#pragma unroll
                for (int hf = 0; hf < 2; ++hf) { const f32x4 gj = *(const f32x4*)(sGc + d * 64 + 32 * kk2 + 16 * hf + 4 * g);
#pragma unroll
                    for (int r = 0; r < 4; ++r) { const int j = 32 * kk2 + 16 * hf + 4 * g + r; const bool ok = (d == 0) ? (j <= i) : (j >= i);
                        float v = st[hf][r] * __expf(gi - gj[r]); asm volatile("" : "+v"(v));
                        p[hf][r] = ok ? v : 0.f; } }
                const int unit = (tc * 8 + h) * 2 + d;
                *(bf16x8*)(F.ws + WS_DW + (size_t)unit * OPS_BYTES + OPS_A + (ib * 2 + kk2) * 1024 + lane * 16) = pack_acc(p[0], p[1]); }
        }
        if (tc_next >= 0) delta_conv_load(F, C, e, tc_next, h, tid); else delta_conv_zero(C);
    }
    TP_END(2) }
    { TP_BEGIN(3)
    __syncthreads();
    TP_END(3) }
    TP_BEGIN(4)
    {
        auto do_w = [&](int d, int mb) { const int unit = (tc * 8 + h) * 2 + d;
            bf16x8 trW[2];
#pragma unroll
            for (int kk = 0; kk < 2; ++kk) { float sb[8];
#pragma unroll
                for (int j = 0; j < 8; ++j) sb[j] = sBe[d * 64 + 32 * kk + 8 * g + j];
                trW[kk] = scale8(ld8(Ti + d * 64 * TSTR + (16 * mb + c) * TSTR + 32 * kk + 8 * g), sb); }
#pragma unroll
            for (int kq = 0; kq < 4; ++kq) { f32x4 wt[2];
#pragma unroll
                for (int hf = 0; hf < 2; ++hf) { const int dk = 16 * (2 * kq + hf) + c; wt[hf] = (f32x4){0.f, 0.f, 0.f, 0.f};
#pragma unroll
                    for (int kk = 0; kk < 2; ++kk) wt[hf] = mfma16(ld8(Kt + dk * TSTR + 32 * kk + 8 * g), trW[kk], wt[hf]); }
                *(bf16x8*)(F.ws + WS_DW + (size_t)unit * OPS_BYTES + OPS_W + (mb * 4 + kq) * 1024 + lane * 16) = pack_acc(wt[0], wt[1]); } };
        auto do_u = [&](int d, int mb) { const int unit = (tc * 8 + h) * 2 + d;
            bf16x8 trU[2];
#pragma unroll
            for (int kk = 0; kk < 2; ++kk) { float bt[8];
#pragma unroll
                for (int j = 0; j < 8; ++j) bt[j] = sBeta[d * 64 + 32 * kk + 8 * g + j];
                trU[kk] = scale8(ld8(Ti + d * 64 * TSTR + (16 * mb + c) * TSTR + 32 * kk + 8 * g), bt); }
            bf16* DU = (bf16*)(F.ws + WS_DU) + (size_t)unit * 8192;
#pragma unroll 4
            for (int nb = 0; nb < 8; ++nb) { const int dv = 16 * nb + c; f32x4 u = {0.f, 0.f, 0.f, 0.f};
#pragma unroll
                for (int kk = 0; kk < 2; ++kk) u = mfma16(trU[kk], ld8(Vt + dv * TSTR + 32 * kk + 8 * g), u);
                u32x2 ub; ub.x = pk2(u[0], u[1]); ub.y = pk2(u[2], u[3]); *(u32x2*)(DU + ((nb * 4 + mb) * 64 + lane) * 4) = ub; } };
        if (wave < 2) {
            if (tc_next >= 0) delta_conv_load(F, C, e, tc_next, h, tid); else delta_conv_zero(C);
            if (tid < 2) ((float*)(F.ws + WS_DG))[(tc * 8 + h) * 2 + tid] = __expf(tid == 0 ? sGc[63] : sGc[64]);
        } else {
            do_w(wave >> 2, wave & 3); do_u(wave >> 2, wave & 3);
            if (wave == 4 || wave == 5) do_w(0, wave - 4);
            if (wave >= 6) do_u(0, wave - 6);
        }
    }
    TP_END(4)
    TP_END(1)
}

__device__ __forceinline__ void ops_dma(LAS unsigned char* dst, const unsigned char* src, int nchunks, int wave, int lane) {
    for (int q = wave; q < nchunks; q += NWAVES)
        __builtin_amdgcn_global_load_lds((const unsigned*)(src + q * 1024 + lane * 16), (LAS unsigned*)(dst + q * 1024), 16, 0, 0);
}
__device__ __forceinline__ void delta_step(const unsigned char* buf, const u32x2 (&uc)[4], float eg, f32x4 (&sacc)[8], f32x4 (&o)[4], int lane) {
    const unsigned char* lb = buf + lane * 16;
    bf16x8 bS[4];
#pragma unroll
    for (int kk = 0; kk < 4; ++kk) bS[kk] = pack_acc(sacc[2 * kk], sacc[2 * kk + 1]);
    f32x4 vn[4];
    bf16x8 fa[8], fb[8], bV[2];
#define DS_LDA(f, i) do { _Pragma("unroll") for (int kk = 0; kk < 4; ++kk) { f[kk] = *(const bf16x8*)(lb + OPS_W + ((i) * 4 + kk) * 1024); f[4 + kk] = *(const bf16x8*)(lb + OPS_Q + ((i) * 4 + kk) * 1024); } } while (0)
#define DS_LDB(f, j) do { _Pragma("unroll") for (int kk = 0; kk < 2; ++kk) { f[kk] = *(const bf16x8*)(lb + OPS_K + ((2 * (j)) * 2 + kk) * 1024); f[2 + kk] = *(const bf16x8*)(lb + OPS_K + ((2 * (j) + 1) * 2 + kk) * 1024); \
        f[4 + kk] = *(const bf16x8*)(lb + OPS_A + ((j) * 2 + kk) * 1024); } } while (0)
#define DS_MMA_A(f, i) do { f32x4 a_ = {0.f, 0.f, 0.f, 0.f}, q_ = {0.f, 0.f, 0.f, 0.f}; _Pragma("unroll") for (int kk = 0; kk < 4; ++kk) { a_ = mfma16(f[kk], bS[kk], a_); q_ = mfma16(f[4 + kk], bS[kk], q_); } \
        const f32x4 u_ = {bf2f(uc[i].x & 0xffffu), bf2f(uc[i].x >> 16), bf2f(uc[i].y & 0xffffu), bf2f(uc[i].y >> 16)}; vn[i] = u_ - a_; o[i] = q_; } while (0)
#define DS_MMA_B(f, j) do { sacc[2 * (j)] = sacc[2 * (j)] * eg; sacc[2 * (j) + 1] = sacc[2 * (j) + 1] * eg; _Pragma("unroll") for (int kk = 0; kk < 2; ++kk) { sacc[2 * (j)] = mfma16(f[kk], bV[kk], sacc[2 * (j)]); \
        sacc[2 * (j) + 1] = mfma16(f[2 + kk], bV[kk], sacc[2 * (j) + 1]); o[j] = mfma16(f[4 + kk], bV[kk], o[j]); } } while (0)
#define DS_SB __builtin_amdgcn_sched_barrier(0)
    DS_LDA(fa, 0); DS_SB;
    DS_LDA(fb, 1); DS_SB; DS_MMA_A(fa, 0); DS_SB;
    DS_LDA(fa, 2); DS_SB; DS_MMA_A(fb, 1); DS_SB;
    DS_LDA(fb, 3); DS_SB; DS_MMA_A(fa, 2); DS_SB;
    DS_LDB(fa, 0); DS_SB; DS_MMA_A(fb, 3); DS_SB;
#pragma unroll
    for (int kk = 0; kk < 2; ++kk) bV[kk] = pack_acc(vn[2 * kk], vn[2 * kk + 1]);
    DS_LDB(fb, 1); DS_SB; DS_MMA_B(fa, 0); DS_SB;
    DS_LDB(fa, 2); DS_SB; DS_MMA_B(fb, 1); DS_SB;
    DS_LDB(fb, 3); DS_SB; DS_MMA_B(fa, 2); DS_SB;
    DS_MMA_B(fb, 3);
#undef DS_LDA
#undef DS_LDB
#undef DS_MMA_A
#undef DS_MMA_B
#undef DS_SB
}
__device__ __forceinline__ void scan_store(bf16* outp, const f32x4 (&o)[4]) {
#pragma unroll
    for (int mb = 0; mb < 4; ++mb)
#pragma unroll
        for (int r = 0; r < 4; ++r) outp[(size_t)(16 * mb + r) * 1024] = (bf16)f2bf(o[mb][r]);
}
#define TOUCH4(u) asm volatile("" : "+v"(u[0]), "+v"(u[1]), "+v"(u[2]), "+v"(u[3]))
__device__ __forceinline__ void delta_scan_unit(Frame& F, int e, int ch) {
    FRESH_IDS();
    TP_BEGIN(10)
    const int c = lane & 15, g = lane >> 4, dv0 = 16 * wave;
    const bool lat = ch >= 256; const int cc = lat ? ch - 256 : ch; const int seq = cc >> 4, h = (cc >> 1) & 7, d = cc & 1;
    const int nchunk = lat ? 16 : 4, tcbase = lat ? 64 + seq * 16 : seq * 4;
    f32x4 sacc[8];
    if (lat) { const float* S0 = F.in[2] + ((size_t)(((seq * 2 + e) * 2 + d) * 8 + h)) * 16384;
#pragma unroll
        for (int mb = 0; mb < 8; ++mb)
#pragma unroll
            for (int r = 0; r < 4; ++r) sacc[mb][r] = S0[(16 * mb + 4 * g + r) * 128 + dv0 + c];
    } else {
#pragma unroll
        for (int mb = 0; mb < 8; ++mb) sacc[mb] = (f32x4){0.f, 0.f, 0.f, 0.f};
    }
    const unsigned char* OPS = F.ws + WS_DW; const bf16* DU = (const bf16*)(F.ws + WS_DU); const float* DG = (const float*)(F.ws + WS_DG);
    bf16* OUT = (bf16*)(F.ws + (d ? WS_OB : WS_OF)) + (size_t)(4 * g) * 1024 + h * 128 + dv0 + c;
    const int uoff = (wave * 4 * 64 + lane) * 4;
    __syncthreads();
#define DUNIT(st) (((tcbase + (d ? nchunk - 1 - (st) : (st))) * 8 + h) * 2 + d)
    u32x2 uA[4], uB[4]; f32x4 oprev[4]; float egA, egB;
    { const int unit = DUNIT(0);
      ops_dma(F.lds, OPS + (size_t)unit * OPS_BYTES, 56, wave, lane);
#pragma unroll
      for (int mb = 0; mb < 4; ++mb) uA[mb] = *(const u32x2*)(DU + (size_t)unit * 8192 + uoff + mb * 256);
      egA = DG[unit]; }
#pragma unroll 1
    for (int step = 0; step < nchunk; step += 2) {
        { TP_BEGIN(17)
        asm volatile("s_waitcnt vmcnt(0)" ::: "memory");
        __syncthreads();
        TP_END(17) }
        TOUCH4(uA); asm volatile("" : "+v"(egA));
        { const int unit = DUNIT(step + 1);
#pragma unroll
          for (int mb = 0; mb < 4; ++mb) uB[mb] = *(const u32x2*)(DU + (size_t)unit * 8192 + uoff + mb * 256);
          egB = DG[unit];
          ops_dma(F.lds + OPS_BYTES, OPS + (size_t)unit * OPS_BYTES, 56, wave, lane); }
        if (step > 0) scan_store(OUT + (size_t)((tcbase + (d ? nchunk - step : step - 1)) * 64) * 1024, oprev);
        delta_step(F.smem, uA, egA, sacc, oprev, lane);
        asm volatile("" ::: "memory");
        { TP_BEGIN(17)
        asm volatile("s_waitcnt vmcnt(0)" ::: "memory");
        __syncthreads();
        TP_END(17) }
        TOUCH4(uB); asm volatile("" : "+v"(egB));
        { const bool more = step + 2 < nchunk; const int unit = DUNIT(more ? step + 2 : step + 1);
#pragma unroll
          for (int mb = 0; mb < 4; ++mb) uA[mb] = *(const u32x2*)(DU + (size_t)unit * 8192 + uoff + mb * 256);
          egA = DG[unit];
          if (more) ops_dma(F.lds, OPS + (size_t)unit * OPS_BYTES, 56, wave, lane); }
        scan_store(OUT + (size_t)((tcbase + (d ? nchunk - 1 - step : step)) * 64) * 1024, oprev);
        delta_step(F.smem + OPS_BYTES, uB, egB, sacc, oprev, lane);
        asm volatile("" ::: "memory");
    }
    scan_store(OUT + (size_t)((tcbase + (d ? 0 : nchunk - 1)) * 64) * 1024, oprev);
#undef DUNIT
    if (!lat) { float* SO = F.out + OUT_SD + ((size_t)(((seq * 2 + e) * 2 + d) * 8 + h)) * 16384;
#pragma unroll
        for (int mb = 0; mb < 8; ++mb)
#pragma unroll
            for (int r = 0; r < 4; ++r) SO[(16 * mb + 4 * g + r) * 128 + dv0 + c] = sacc[mb][r]; }
    if (ch >= 256) { TP_END(10) }
}

struct CombRow { float v[16]; bf16x8 z0, z1, kv; };
__device__ __forceinline__ void comb_even_load(Frame& F, CombRow& R, int row, int lane) {
    const bf16* OF = (const bf16*)(F.ws + WS_OF) + (size_t)row * 1024 + 16 * lane; const bf16* OB = (const bf16*)(F.ws + WS_OB) + (size_t)row * 1024 + 16 * lane;
    const bf16* P = (const bf16*)(F.ws + WS_P) + (size_t)row * LDP_E;
#pragma unroll
    for (int q = 0; q < 2; ++q) { const bf16x8 a = ld8(OF + 8 * q), b = ld8(OB + 8 * q);
#pragma unroll
        for (int r = 0; r < 8; ++r) R.v[8 * q + r] = bf2f((unsigned short)a[r]) + bf2f((unsigned short)b[r]); }
    R.z0 = ld8(P + E_ZA + 16 * lane); R.z1 = ld8(P + E_ZA + 16 * lane + 8);
    R.kv = ld8(P + E_KB + 8 * lane);
}
__device__ __forceinline__ void comb_even_finish(Frame& F, const CombRow& R, int row, int e, int lane, const float (&on)[16]) {
    const int ch0 = 16 * lane;
    float ss = 0.f;
#pragma unroll
    for (int i = 0; i < 16; ++i) ss += R.v[i] * R.v[i];
    ss = xsum<1>(ss); ss = xsum<2>(ss); ss = xsum<4>(ss);
    const float rstd = rsqrtf(ss * (1.f / 128.f) + EPSF);
    unsigned w[8];
#pragma unroll
    for (int q = 0; q < 8; ++q) { float o2[2];
#pragma unroll
        for (int hh = 0; hh < 2; ++hh) { const int i = 2 * q + hh; const float z = bf2f((unsigned short)(i < 8 ? R.z0[i] : R.z1[i - 8]));
            o2[hh] = R.v[i] * rstd * on[i] * siluf(z); }
        w[q] = pk2(o2[0], o2[1]); }
    bf16* OM = (bf16*)(F.ws + WS_OMIX) + (size_t)row * DM + ch0;
    u32x4 w0, w1; w0.x = w[0]; w0.y = w[1]; w0.z = w[2]; w0.w = w[3]; w1.x = w[4]; w1.y = w[5]; w1.z = w[6]; w1.w = w[7];
    *(u32x4*)OM = w0; *(u32x4*)(OM + 8) = w1;
    if (row < MCTX) {
        const int b = row >> 8, t = row & 255, which = lane >> 5, off = 8 * (lane & 31);
        float* dst = F.out + OUT_KVW + ((size_t)((b * 2 + e) * 2 + which) * 256 + t) * 256 + off;
        f32x4 a, bb;
#pragma unroll
        for (int r = 0; r < 4; ++r) { a[r] = bf2f((unsigned short)R.kv[r]); bb[r] = bf2f((unsigned short)R.kv[4 + r]); }
        *(f32x4*)dst = a; *(f32x4*)(dst + 4) = bb;
    }
}
__device__ __forceinline__ void phase_combine_even(Frame& F, int e) {
    FRESH_IDS();
    const int gw = F.bid * NWAVES + wave, NGW = F.G * NWAVES;
    float on[16];
#pragma unroll
    for (int i = 0; i < 16; ++i) on[i] = F.in[15][e * 128 + ((16 * lane + i) & 127)];
    for (int rowb = gw; rowb < MROWS; rowb += 4 * NGW) {
        CombRow R[4]; int rows[4];
#pragma unroll
        for (int q = 0; q < 4; ++q) { rows[q] = (rowb + q * NGW < MROWS) ? rowb + q * NGW : rowb; comb_even_load(F, R[q], rows[q], lane); }
#pragma unroll
        for (int q = 0; q < 4; ++q) { if (q > 0 && rows[q] == rowb) continue; comb_even_finish(F, R[q], rows[q], e, lane, on); }
    }
}

constexpr int GOPS_BYTES = 41984, GOPS_Q = 0, GOPS_K = 16384, GOPS_A = 32768, GOPS_D = 40960;
constexpr int BSTR = 132;
constexpr int GP_QS = 0, GP_KS = 17408, GP_KT = 34816, GP_BB = 53248, GP_LR = 87040, GP_VT = 95232, GP_QG = 95232, GP_KN = 112640;
static_assert(GP_VT + 36864 <= LDS_MISC && GP_KN + 17408 <= LDS_MISC, "gla prep LDS");

__device__ __forceinline__ void gla_prep_unit(Frame& F, int o, int tc, int h) {
    FRESH_IDS();
    TP_BEGIN(21)
    TP_BEGIN(22)
    bf16* Qs = (bf16*)(F.smem + GP_QS); bf16* Ks = (bf16*)(F.smem + GP_KS); bf16* Kt = (bf16*)(F.smem + GP_KT); bf16* Vt = (bf16*)(F.smem + GP_VT);
    bf16* Qg = (bf16*)(F.smem + GP_QG); bf16* Kn = (bf16*)(F.smem + GP_KN);
    float* BB = (float*)(F.smem + GP_BB); float* LR = (float*)(F.smem + GP_LR);
    const int m0 = tc * 64, c = lane & 15, g = lane >> 4;
    const bf16* P = (const bf16*)(F.ws + WS_P); const float* SM = (const float*)(F.ws + WS_SM);
    float wv2[2][16], bias2[2];
#pragma unroll
    for (int d = 0; d < 2; ++d) { bias2[d] = F.in[20][(size_t)(o * 2 + d) * 512 + h * 128 + (tid & 127)];
#pragma unroll
        for (int r = 0; r < 16; ++r) wv2[d][r] = F.in[19][((size_t)(o * 2 + d) * 16 + r) * 512 + h * 128 + (tid & 127)]; }
    bf16x8 qv[2], kv[2], vv[4]; float lrv[4];
#pragma unroll
    for (int it = 0; it < 2; ++it) { const int idx = tid + NTHREADS * it, i = idx & 63, c8 = idx >> 6;
        qv[it] = ld8(P + (size_t)(m0 + i) * LDP_O + O_QC + h * 128 + 8 * c8); kv[it] = ld8(P + (size_t)(m0 + i) * LDP_O + O_KC + h * 128 + 8 * c8); }
#pragma unroll
    for (int it = 0; it < 4; ++it) { const int idx = tid + NTHREADS * it, i = idx & 63, dg = idx >> 6; vv[it] = ld8(P + (size_t)(m0 + i) * LDP_O + O_VC + h * 256 + 8 * dg); }
#pragma unroll
    for (int it = 0; it < 4; ++it) { const int idx = tid + NTHREADS * it; lrv[it] = SM[(size_t)(m0 + (idx >> 5)) * 32 + (idx & 31)]; }
    __syncthreads();
#pragma unroll
    for (int it = 0; it < 2; ++it) { const int idx = tid + NTHREADS * it, i = idx & 63, c8 = idx >> 6;
        const bf16x8 q = qv[it], k = kv[it];
        u32x4 ww;
#pragma unroll
        for (int jp = 0; jp < 4; ++jp) ww[jp] = pk2(bf2f((unsigned short)q[2 * jp]) * ATT_SCALE, bf2f((unsigned short)q[2 * jp + 1]) * ATT_SCALE);
        *(u32x4*)(Qs + i * QSTR + 8 * c8) = ww; *(bf16x8*)(Ks + i * QSTR + 8 * c8) = k;
#pragma unroll
        for (int r = 0; r < 8; ++r) Kt[(8 * c8 + r) * TSTR + i] = (bf16)k[r]; }
#pragma unroll
    for (int it = 0; it < 4; ++it) { const int idx = tid + NTHREADS * it, i = idx & 63, dg = idx >> 6;
        const bf16x8 v = vv[it];
#pragma unroll
        for (int r = 0; r < 8; ++r) Vt[(8 * dg + r) * TSTR + i] = (bf16)v[r]; }
#pragma unroll
    for (int it = 0; it < 4; ++it) LR[tid + NTHREADS * it] = lrv[it];
    __syncthreads();
    TP_END(22)
    TP_BEGIN(23)
    { unsigned char* GV = F.ws + WS_GV + (size_t)(tc * 4 + h) * 32768;
#pragma unroll
      for (int q = 0; q < 4; ++q) { const int f = wave * 4 + q, nb = f >> 1, kk = f & 1;
          *(bf16x8*)(GV + f * 1024 + lane * 16) = ld44(Vt + (16 * nb + c) * TSTR + 32 * kk + 4 * g, Vt + (16 * nb + c) * TSTR + 32 * kk + 16 + 4 * g); } }
    __syncthreads();
    TP_END(23)
#pragma unroll 1
    for (int d = 0; d < 2; ++d) {
        unsigned char* GO = F.ws + WS_GO + (size_t)((tc * 4 + h) * 2 + d) * GOPS_BYTES;
        TP_BEGIN(24)
        { const int dk = tid & 127, i0 = (tid >> 7) * 16;
          float wv[16];
#pragma unroll
          for (int r = 0; r < 16; ++r) wv[r] = d ? wv2[1][r] : wv2[0][r];
          const float bias = d ? bias2[1] : bias2[0];
          float run = 0.f;
#pragma unroll 4
          for (int ii = 0; ii < 16; ++ii) { const int i = i0 + (d == 0 ? ii : 15 - ii); float s = bias;
#pragma unroll
              for (int r = 0; r < 16; ++r) s += LR[i * 32 + 16 * d + r] * wv[r];
              run += logsigmoidf_(s) * (1.f / 16.f); BB[i * BSTR + dk] = run; }
        }
        __syncthreads();
        { const int dk = tid & 127, qd = tid >> 7, i0 = qd * 16; float off = 0.f;
          if (d == 0) { for (int qq = 0; qq < qd; ++qq) off += BB[(qq * 16 + 15) * BSTR + dk]; }
          else { for (int qq = qd + 1; qq < 4; ++qq) off += BB[(qq * 16) * BSTR + dk]; }
          __syncthreads();
          for (int ii = 0; ii < 16; ++ii) BB[(i0 + ii) * BSTR + dk] += off; }
        __syncthreads();
        TP_END(24)
        TP_BEGIN(25)
#pragma unroll 4
        for (int it = 0; it < 16; ++it) { const int idx = tid + 512 * it, i = idx >> 7, dk = idx & 127;
            const float b = BB[i * BSTR + dk];
            Qg[i * QSTR + dk] = (bf16)f2bf(bf2f(Qs[i * QSTR + dk]) * __expf(b)); Kn[i * QSTR + dk] = (bf16)f2bf(bf2f(Ks[i * QSTR + dk]) * __expf(-b)); }
        const int blrow = (d == 0) ? 63 : 0;
#pragma unroll
        for (int q = 0; q < 2; ++q) { const int fi = wave * 2 + q;
            { const int mb = fi >> 2, kk = fi & 3, i = 16 * mb + c;
              const bf16x8 v = ld44(Qs + i * QSTR + 32 * kk + 4 * g, Qs + i * QSTR + 32 * kk + 16 + 4 * g);
              const f32x4 b0 = *(const f32x4*)(BB + i * BSTR + 32 * kk + 4 * g), b1 = *(const f32x4*)(BB + i * BSTR + 32 * kk + 16 + 4 * g);
              const float s8[8] = {__expf(b0[0]), __expf(b0[1]), __expf(b0[2]), __expf(b0[3]), __expf(b1[0]), __expf(b1[1]), __expf(b1[2]), __expf(b1[3])};
              *(bf16x8*)(GO + GOPS_Q + fi * 1024 + lane * 16) = scale8(v, s8); }
            { const int mb = fi >> 1, kk = fi & 1, dk = 16 * mb + c;
              const bf16x8 v = ld44(Kt + dk * TSTR + 32 * kk + 4 * g, Kt + dk * TSTR + 32 * kk + 16 + 4 * g);
              const float bl = BB[blrow * BSTR + dk]; float s8[8];
#pragma unroll
              for (int jj = 0; jj < 8; ++jj) s8[jj] = __expf(bl - BB[(32 * kk + 16 * (jj >> 2) + 4 * g + (jj & 3)) * BSTR + dk]);
              *(bf16x8*)(GO + GOPS_K + fi * 1024 + lane * 16) = scale8(v, s8); } }
        if (tid < 128) *(float*)(GO + GOPS_D + tid * 4) = __expf(BB[blrow * BSTR + tid]);
        __syncthreads();
        TP_END(25)
        TP_BEGIN(26)
        {
            const int ib = wave >> 1, kk2 = wave & 1, i = 16 * ib + c;
            f32x4 st[2];
#pragma unroll
            for (int hf = 0; hf < 2; ++hf) { const bf16* A = Kn + (16 * (2 * kk2 + hf) + c) * QSTR + 8 * g; const bf16* B = Qg + (16 * ib + c) * QSTR + 8 * g;
                st[hf] = (f32x4){0.f, 0.f, 0.f, 0.f};
#pragma unroll
                for (int kk = 0; kk < 4; ++kk) st[hf] = mfma16(ld8(A + 32 * kk), ld8(B + 32 * kk), st[hf]);
#pragma unroll
                for (int r = 0; r < 4; ++r) { const int j = 32 * kk2 + 16 * hf + 4 * g + r; const bool ok = (d == 0) ? (j <= i) : (j >= i); if (!ok) st[hf][r] = 0.f; } }
            *(bf16x8*)(GO + GOPS_A + (ib * 2 + kk2) * 1024 + lane * 16) = pack_acc(st[0], st[1]);
        }
        __syncthreads();
        TP_END(26)
    }
    TP_END(21)
}

__device__ __forceinline__ void gla_step(const unsigned char* buf, const bf16x8 (&bV)[2], f32x4 (&sacc)[8], f32x4 (&o)[4], int lane, int g) {
    const unsigned char* lb = buf + lane * 16;
    bf16x8 bS[4];
#pragma unroll
    for (int kk = 0; kk < 4; ++kk) bS[kk] = pack_acc(sacc[2 * kk], sacc[2 * kk + 1]);
    bf16x8 fa[6], fb[6]; f32x4 da[2], db[2];
#define GS_LDA(f, i) do { _Pragma("unroll") for (int kk = 0; kk < 4; ++kk) f[kk] = *(const bf16x8*)(lb + GOPS_Q + ((i) * 4 + kk) * 1024); \
        _Pragma("unroll") for (int kk = 0; kk < 2; ++kk) f[4 + kk] = *(const bf16x8*)(lb + GOPS_A + ((i) * 2 + kk) * 1024); } while (0)
#define GS_LDB(f, dd, j) do { _Pragma("unroll") for (int q_ = 0; q_ < 2; ++q_) { dd[q_] = *(const f32x4*)(buf + GOPS_D + (16 * (2 * (j) + q_) + 4 * g) * 4); \
        _Pragma("unroll") for (int kk = 0; kk < 2; ++kk) f[2 * q_ + kk] = *(const bf16x8*)(lb + GOPS_K + ((2 * (j) + q_) * 2 + kk) * 1024); } } while (0)
#define GS_MMA_A(f, i) do { f32x4 ov = {0.f, 0.f, 0.f, 0.f}; _Pragma("unroll") for (int kk = 0; kk < 4; ++kk) ov = mfma16(f[kk], bS[kk], ov); \
        _Pragma("unroll") for (int kk = 0; kk < 2; ++kk) ov = mfma16(f[4 + kk], bV[kk], ov); o[i] = ov; } while (0)
#define GS_MMA_B(f, dd, j) do { _Pragma("unroll") for (int q_ = 0; q_ < 2; ++q_) { sacc[2 * (j) + q_] = sacc[2 * (j) + q_] * dd[q_]; \
        _Pragma("unroll") for (int kk = 0; kk < 2; ++kk) sacc[2 * (j) + q_] = mfma16(f[2 * q_ + kk], bV[kk], sacc[2 * (j) + q_]); } } while (0)
#define GS_SB __builtin_amdgcn_sched_barrier(0)
    GS_LDA(fa, 0); GS_SB;
    GS_LDA(fb, 1); GS_SB; GS_MMA_A(fa, 0); GS_SB;
    GS_LDA(fa, 2); GS_SB; GS_MMA_A(fb, 1); GS_SB;
    GS_LDA(fb, 3); GS_SB; GS_MMA_A(fa, 2); GS_SB;
    GS_LDB(fa, da, 0); GS_SB; GS_MMA_A(fb, 3); GS_SB;
    GS_LDB(fb, db, 1); GS_SB; GS_MMA_B(fa, da, 0); GS_SB;
    GS_LDB(fa, da, 2); GS_SB; GS_MMA_B(fb, db, 1); GS_SB;
    GS_LDB(fb, db, 3); GS_SB; GS_MMA_B(fa, da, 2); GS_SB;
    GS_MMA_B(fb, db, 3);
#undef GS_LDA
#undef GS_LDB
#undef GS_MMA_A
#undef GS_MMA_B
#undef GS_SB
}
__device__ __forceinline__ void gla_scan_unit(Frame& F, int o, int ch, int half) {
    FRESH_IDS();
    const int c = lane & 15, g = lane >> 4, nb = 8 * half + wave, dv0 = 16 * nb;
    const bool lat = ch >= 128; const int cc = lat ? ch - 128 : ch; const int seq = cc >> 3, h = (cc >> 1) & 3, d = cc & 1;
    const int nchunk = lat ? 16 : 4, tcbase = lat ? 64 + seq * 16 : seq * 4;
    f32x4 sacc[8];
    if (lat) { const float* S0 = F.in[4] + ((size_t)(((seq * 2 + o) * 2 + d) * 4 + h)) * 32768;
#pragma unroll
        for (int mb = 0; mb < 8; ++mb)
#pragma unroll
            for (int r = 0; r < 4; ++r) sacc[mb][r] = S0[(16 * mb + 4 * g + r) * 256 + dv0 + c];
    } else {
#pragma unroll
        for (int mb = 0; mb < 8; ++mb) sacc[mb] = (f32x4){0.f, 0.f, 0.f, 0.f};
    }
    const unsigned char* GO = F.ws + WS_GO; const unsigned char* GV = F.ws + WS_GV + (size_t)nb * 2048 + lane * 16;
    bf16* OUT = (bf16*)(F.ws + (d ? WS_OB : WS_OF)) + (size_t)(4 * g) * 1024 + h * 256 + dv0 + c;
    __syncthreads();
#define GTC(st) (tcbase + (d ? nchunk - 1 - (st) : (st)))
    bf16x8 vA[2], vB[2]; f32x4 oprev[4];
    { const int tc = GTC(0);
      ops_dma(F.lds, GO + (size_t)((tc * 4 + h) * 2 + d) * GOPS_BYTES, 41, wave, lane);
      vA[0] = *(const bf16x8*)(GV + (size_t)(tc * 4 + h) * 32768); vA[1] = *(const bf16x8*)(GV + (size_t)(tc * 4 + h) * 32768 + 1024); }
#pragma unroll 1
    for (int step = 0; step < nchunk; step += 2) {
        asm volatile("s_waitcnt vmcnt(0)" ::: "memory");
        __syncthreads();
        asm volatile("" : "+v"(vA[0]), "+v"(vA[1]));
        { const int tc = GTC(step + 1);
          vB[0] = *(const bf16x8*)(GV + (size_t)(tc * 4 + h) * 32768); vB[1] = *(const bf16x8*)(GV + (size_t)(tc * 4 + h) * 32768 + 1024);
          ops_dma(F.lds + GOPS_BYTES, GO + (size_t)((tc * 4 + h) * 2 + d) * GOPS_BYTES, 41, wave, lane); }
        if (step > 0) scan_store(OUT + (size_t)(GTC(step - 1) * 64) * 1024, oprev);
        gla_step(F.smem, vA, sacc, oprev, lane, g);
        asm volatile("" ::: "memory");
        asm volatile("s_waitcnt vmcnt(0)" ::: "memory");
        __syncthreads();
        asm volatile("" : "+v"(vB[0]), "+v"(vB[1]));
        { const bool more = step + 2 < nchunk; const int tc = GTC(more ? step + 2 : step + 1);
          vA[0] = *(const bf16x8*)(GV + (size_t)(tc * 4 + h) * 32768); vA[1] = *(const bf16x8*)(GV + (size_t)(tc * 4 + h) * 32768 + 1024);
          if (more) ops_dma(F.lds, GO + (size_t)((tc * 4 + h) * 2 + d) * GOPS_BYTES, 41, wave, lane); }
        scan_store(OUT + (size_t)(GTC(step) * 64) * 1024, oprev);
        gla_step(F.smem + GOPS_BYTES, vB, sacc, oprev, lane, g);
        asm volatile("" ::: "memory");
    }
    scan_store(OUT + (size_t)(GTC(nchunk - 1) * 64) * 1024, oprev);
#undef GTC
    if (!lat) { float* SO = F.out + OUT_SG + ((size_t)(((seq * 2 + o) * 2 + d) * 4 + h)) * 32768;
#pragma unroll
        for (int mb = 0; mb < 8; ++mb)
#pragma unroll
            for (int r = 0; r < 4; ++r) SO[(16 * mb + 4 * g + r) * 256 + dv0 + c] = sacc[mb][r]; }
}

struct CombRowO { float v[16]; bf16x8 z0, z1, kv[4], od0, od1, zd0, zd1; };
__device__ __forceinline__ void comb_odd_load(Frame& F, CombRowO& R, int row, int lane) {
    const bf16* OF = (const bf16*)(F.ws + WS_OF) + (size_t)row * 1024 + 16 * lane; const bf16* OB = (const bf16*)(F.ws + WS_OB) + (size_t)row * 1024 + 16 * lane;
    const bf16* P = (const bf16*)(F.ws + WS_P) + (size_t)row * LDP_O;
#pragma unroll
    for (int q = 0; q < 2; ++q) { const bf16x8 a = ld8(OF + 8 * q), b = ld8(OB + 8 * q);
#pragma unroll
        for (int r = 0; r < 8; ++r) R.v[8 * q + r] = bf2f((unsigned short)a[r]) + bf2f((unsigned short)b[r]); }
    R.z0 = ld8(P + O_ZC + 16 * lane); R.z1 = ld8(P + O_ZC + 16 * lane + 8);
    R.zd0 = ld8(P + O_ZD + 16 * lane); R.zd1 = ld8(P + O_ZD + 16 * lane + 8);
    { const bf16* OD = (const bf16*)(F.ws + WS_OMIX) + (size_t)row * DM + 1024 + 16 * lane; R.od0 = ld8(OD); R.od1 = ld8(OD + 8); }
    if (row < MCTX) {
#pragma unroll
        for (int q = 0; q < 4; ++q) R.kv[q] = ld8(P + O_KD + 8 * lane + 512 * q);
    }
}
__device__ __forceinline__ void comb_odd_finish(Frame& F, const CombRowO& R, int row, int o, int lane, const float (&on)[16]) {
    const int ch0 = 16 * lane;
    float ss = 0.f;
#pragma unroll
    for (int i = 0; i < 16; ++i) ss += R.v[i] * R.v[i];
    ss = xsum<1>(ss); ss = xsum<2>(ss); ss = xsum<4>(ss); ss = xsum<8>(ss);
    const float rstd = rsqrtf(ss * (1.f / 256.f) + EPSF);
    unsigned w[8];
#pragma unroll
    for (int q = 0; q < 8; ++q) { float o2[2];
#pragma unroll
        for (int hh = 0; hh < 2; ++hh) { const int i = 2 * q + hh; const float z = bf2f((unsigned short)(i < 8 ? R.z0[i] : R.z1[i - 8]));
            o2[hh] = R.v[i] * rstd * on[i] * siluf(z); }
        w[q] = pk2(o2[0], o2[1]); }
    bf16* OM = (bf16*)(F.ws + WS_OMIX) + (size_t)row * DM + ch0;
    u32x4 w0, w1; w0.x = w[0]; w0.y = w[1]; w0.z = w[2]; w0.w = w[3]; w1.x = w[4]; w1.y = w[5]; w1.z = w[6]; w1.w = w[7];
    *(u32x4*)OM = w0; *(u32x4*)(OM + 8) = w1;
    { u32x4 g0, g1;
#pragma unroll
      for (int q = 0; q < 4; ++q) { g0[q] = pk2(bf2f((unsigned short)R.od0[2 * q]) * siluf(bf2f((unsigned short)R.zd0[2 * q])), bf2f((unsigned short)R.od0[2 * q + 1]) * siluf(bf2f((unsigned short)R.zd0[2 * q + 1])));
                                    g1[q] = pk2(bf2f((unsigned short)R.od1[2 * q]) * siluf(bf2f((unsigned short)R.zd1[2 * q])), bf2f((unsigned short)R.od1[2 * q + 1]) * siluf(bf2f((unsigned short)R.zd1[2 * q + 1]))); }
      *(u32x4*)(OM + 1024) = g0; *(u32x4*)(OM + 1024 + 8) = g1; }
    if (row < MCTX) {
        const int b = row >> 8, t = row & 255;
#pragma unroll
        for (int q = 0; q < 4; ++q) { const int e0 = 8 * lane + 512 * q, which = e0 >> 10, off = e0 & 1023;
            float* dst = F.out + OUT_KVN + ((size_t)((b * 2 + o) * 2 + which) * 256 + t) * 1024 + off;
            f32x4 a, bb;
#pragma unroll
            for (int r = 0; r < 4; ++r) { a[r] = bf2f((unsigned short)R.kv[q][r]); bb[r] = bf2f((unsigned short)R.kv[q][4 + r]); }
            *(f32x4*)dst = a; *(f32x4*)(dst + 4) = bb; }
    }
}
__device__ __forceinline__ void phase_combine_odd(Frame& F, int o) {
    FRESH_IDS();
    const int gw = F.bid * NWAVES + wave, NGW = F.G * NWAVES;
    float on[16];
#pragma unroll
    for (int i = 0; i < 16; ++i) on[i] = F.in[21][o * 256 + ((16 * lane + i) & 255)];
    for (int row0 = gw; row0 < MROWS; row0 += 2 * NGW) {
        const int row1 = row0 + NGW; const bool two = row1 < MROWS;
        CombRowO A, B;
        comb_odd_load(F, A, row0, lane); comb_odd_load(F, B, two ? row1 : row0, lane);
        comb_odd_finish(F, A, row0, o, lane, on); if (two) comb_odd_finish(F, B, row1, o, lane, on);
    }
}

__device__ __forceinline__ void rope_table(Frame& F) {
    FRESH_IDS();
    for (int idx = F.bid * NTHREADS + tid; idx < 64 * 32; idx += F.G * NTHREADS) { const int pos = idx >> 5, i = idx & 31;
        const float freq = __expf(-(float)i * (9.210340371976184f / 32.f)); float sn, cs; sincosf((float)pos * freq, &sn, &cs);
        float* tab = (float*)(F.ws + WS_ROPE) + idx * 2; tab[0] = cs; tab[1] = sn; }
}

constexpr int AT_TILE = 32768, AT_V = 16384;
__device__ __forceinline__ void vfrag_store(unsigned char* dst, const unsigned (&vw)[8], int r, int lane) {
    u32x4 ae, ao;
    ae.x = (vw[0] & 0xffffu) | (vw[1] << 16); ae.y = (vw[2] & 0xffffu) | (vw[3] << 16); ae.z = (vw[4] & 0xffffu) | (vw[5] << 16); ae.w = (vw[6] & 0xffffu) | (vw[7] << 16);
    ao.x = (vw[0] >> 16) | (vw[1] & 0xffff0000u); ao.y = (vw[2] >> 16) | (vw[3] & 0xffff0000u); ao.z = (vw[4] >> 16) | (vw[5] & 0xffff0000u); ao.w = (vw[6] >> 16) | (vw[7] & 0xffff0000u);
    *(u32x4*)(dst + AT_V + (2 * r) * 1024 + lane * 16) = ae; *(u32x4*)(dst + AT_V + (2 * r + 1) * 1024 + lane * 16) = ao;
}
template <bool ROPE>
__device__ __forceinline__ void tile_build_bf16(unsigned char* dst, const bf16* k0, int kld, const bf16* v0, int vld, int r, int lane, const float* ropetab, int posrow, int poscol0) {
    const int c = lane & 15, g = lane >> 4, keyblk = r >> 1, kkb = 2 * (r & 1);
    const bf16* kp = k0 + (size_t)(16 * keyblk + c) * kld + 8 * g;
    bf16x8 ka = ld8(kp + 32 * kkb), kb = ld8(kp + 32 * (kkb + 1));
    unsigned vw[8]; const int s = r >> 2, dq = r & 3;
#pragma unroll
    for (int j = 0; j < 8; ++j) { const int key = 32 * s + 16 * (j >> 2) + 4 * g + (j & 3); vw[j] = *(const unsigned*)(v0 + (size_t)key * vld + 32 * dq + 2 * c); }
    if (ROPE) { const int pos = (r & 1) ? (poscol0 + 16 * keyblk + c) : posrow; const f32x4* tab = (const f32x4*)(ropetab + (pos * 32 + 8 * g) * 2);
        u32x4 wa, wb;
#pragma unroll
        for (int jp = 0; jp < 4; ++jp) { const f32x4 t4 = tab[jp];
            const float a0 = bf2f((unsigned short)ka[2 * jp]), a1 = bf2f((unsigned short)ka[2 * jp + 1]), b0 = bf2f((unsigned short)kb[2 * jp]), b1 = bf2f((unsigned short)kb[2 * jp + 1]);
            wa[jp] = pk2(a0 * t4[0] - b0 * t4[1], a1 * t4[2] - b1 * t4[3]); wb[jp] = pk2(b0 * t4[0] + a0 * t4[1], b1 * t4[2] + a1 * t4[3]); }
        ka = __builtin_bit_cast(bf16x8, wa); kb = __builtin_bit_cast(bf16x8, wb); }
    *(bf16x8*)(dst + (2 * r) * 1024 + lane * 16) = ka; *(bf16x8*)(dst + (2 * r + 1) * 1024 + lane * 16) = kb;
    vfrag_store(dst, vw, r, lane);
}
struct TileRole { bf16x8 ka, kb; unsigned vw[8]; };
__device__ __forceinline__ void tile_role_load(TileRole& T, const bf16* k0, int kld, const bf16* v0, int vld, int r, int lane) {
    const int c = lane & 15, g = lane >> 4, keyblk = r >> 1, kkb = 2 * (r & 1), s = r >> 2, dq = r & 3;
    const bf16* kp = k0 + (size_t)(16 * keyblk + c) * kld + 8 * g;
    T.ka = ld8(kp + 32 * kkb); T.kb = ld8(kp + 32 * (kkb + 1));
#pragma unroll
    for (int j = 0; j < 8; ++j) { const int key = 32 * s + 16 * (j >> 2) + 4 * g + (j & 3); T.vw[j] = *(const unsigned*)(v0 + (size_t)key * vld + 32 * dq + 2 * c); }
}
__device__ __forceinline__ void tile_role_store(const TileRole& T, unsigned char* dst, int r, int lane) {
    *(bf16x8*)(dst + (2 * r) * 1024 + lane * 16) = T.ka; *(bf16x8*)(dst + (2 * r + 1) * 1024 + lane * 16) = T.kb;
    vfrag_store(dst, T.vw, r, lane);
}
__device__ __forceinline__ void tile_build_f32(unsigned char* dst, const float* k0, const float* v0, int ld, int r, int lane) {
    const int c = lane & 15, g = lane >> 4, keyblk = r >> 1, kkb = 2 * (r & 1);
    const float* kp = k0 + (size_t)(16 * keyblk + c) * ld + 8 * g;
    const bf16x8 ka = ld8_f32(kp + 32 * kkb), kb = ld8_f32(kp + 32 * (kkb + 1));
    unsigned vw[8]; const int s = r >> 2, dq = r & 3;
#pragma unroll
    for (int j = 0; j < 8; ++j) { const int key = 32 * s + 16 * (j >> 2) + 4 * g + (j & 3); const f32x2_t v = *(const f32x2_t*)(v0 + (size_t)key * ld + 32 * dq + 2 * c); vw[j] = pk2(v[0], v[1]); }
    *(bf16x8*)(dst + (2 * r) * 1024 + lane * 16) = ka; *(bf16x8*)(dst + (2 * r + 1) * 1024 + lane * 16) = kb;
    vfrag_store(dst, vw, r, lane);
}
__device__ __forceinline__ void cache_tiles(Frame& F) {
    FRESH_IDS();
    const int gw = F.bid * NWAVES + wave, NGW = F.G * NWAVES;
    for (int job = gw; job < 320 * 8; job += NGW) { const int tile = job >> 3, r = job & 7;
        if (tile < 64) { const int t = tile & 3, kvh = (tile >> 2) & 1, b = (tile >> 3) & 3, e = tile >> 5;
            const float* k0 = F.in[3] + ((size_t)((b * 2 + e) * 2 + 0) * 256 + 64 * t) * 256 + kvh * 128;
            tile_build_f32(F.ws + WS_TCACHE_E + (size_t)tile * AT_TILE, k0, k0 + 65536, 256, r, lane); }
        else { const int tl = tile - 64, t = tl & 3, h = (tl >> 2) & 7, b = (tl >> 5) & 3, o = tl >> 7;
            const float* k0 = F.in[5] + ((size_t)((b * 2 + o) * 2 + 0) * 256 + 64 * t) * 1024 + h * 128;
            tile_build_f32(F.ws + WS_TCACHE_O + (size_t)tl * AT_TILE, k0, k0 + 262144, 1024, r, lane); } }
}
__device__ __forceinline__ void kv_tiles(Frame& F, int li) {
    FRESH_IDS();
    const int gw = F.bid * NWAVES + wave, NGW = F.G * NWAVES;
    const bf16* P = (const bf16*)(F.ws + WS_P);
    if (li & 1) {
        for (int job0 = gw; job0 < 1024 * 8; job0 += 4 * NGW) {
            TileRole T[4]; unsigned char* dst[4]; int rr[4]; bool ok[4];
#pragma unroll
            for (int q = 0; q < 4; ++q) { const int job = job0 + q * NGW; ok[q] = job < 1024 * 8; const int tile = (ok[q] ? job : job0) >> 3; rr[q] = (ok[q] ? job : job0) & 7;
                const bf16* k0;
                if (tile < 512) { const int t = tile & 3, h = (tile >> 2) & 7, b = tile >> 5; k0 = P + (size_t)(b * 256 + 64 * t) * LDP_O + O_KD + h * 128; dst[q] = F.ws + WS_TCTX + (size_t)tile * AT_TILE; }
                else { const int tl = tile - 512, row = tl & 15, h = (tl >> 4) & 7, b = tl >> 7; k0 = P + (size_t)(MCTX + b * 1024 + 64 * row) * LDP_O + O_KD + h * 128; dst[q] = F.ws + WS_TLAT + (size_t)tl * AT_TILE; }
                tile_role_load(T[q], k0, LDP_O, k0 + (O_VD - O_KD), LDP_O, rr[q], lane); }
#pragma unroll
            for (int q = 0; q < 4; ++q) if (ok[q]) tile_role_store(T[q], dst[q], rr[q], lane);
        }
    } else {
        for (int job = gw; job < 256 * 8; job += NGW) { const int tile = job >> 3, r = job & 7;
            if (tile < 128) { const int t = tile & 3, kvh = (tile >> 2) & 1, b = tile >> 3;
                const bf16* k0 = P + (size_t)(b * 256 + 64 * t) * LDP_E + E_KB + kvh * 128;
                tile_build_bf16<false>(F.ws + WS_TCTX + (size_t)tile * AT_TILE, k0, LDP_E, k0 + (E_VB - E_KB), LDP_E, r, lane, nullptr, 0, 0); }
            else { const int tl = tile - 128, t = tl & 15, kvh = (tl >> 4) & 1, b = tl >> 5;
                const bf16* k0 = P + (size_t)(MCTX + b * 1024 + 64 * t) * LDP_E + E_KB + kvh * 128;
                tile_build_bf16<true>(F.ws + WS_TLAT + (size_t)tl * AT_TILE, k0, LDP_E, k0 + (E_VB - E_KB), LDP_E, r, lane, (const float*)(F.ws + WS_ROPE), t, 0); } }
    }
}

struct AttnState { f32x4 o[4][2]; float m, l; };
__device__ __forceinline__ void attn_step(AttnState& st, const bf16x8 (&qf)[4], const unsigned char* buf, int s, const float (&bias)[8], unsigned okmask, int lane) {
    const unsigned char* lb = buf + lane * 16;
    bf16x8 kf[2][4], vf[4][2];
#pragma unroll
    for (int hf = 0; hf < 2; ++hf)
#pragma unroll
        for (int kk = 0; kk < 4; ++kk) kf[hf][kk] = *(const bf16x8*)(lb + ((2 * s + hf) * 4 + kk) * 1024);
#pragma unroll
    for (int dq = 0; dq < 4; ++dq)
#pragma unroll
        for (int par = 0; par < 2; ++par) vf[dq][par] = *(const bf16x8*)(lb + AT_V + ((s * 4 + dq) * 2 + par) * 1024);
    __builtin_amdgcn_sched_barrier(0);
    f32x4 sc[2];
    __builtin_amdgcn_s_setprio(1);
#pragma unroll
    for (int hf = 0; hf < 2; ++hf) { sc[hf] = (f32x4){0.f, 0.f, 0.f, 0.f};
#pragma unroll
        for (int kk = 0; kk < 4; ++kk) sc[hf] = mfma16(kf[hf][kk], qf[kk], sc[hf]); }
    __builtin_amdgcn_s_setprio(0);
    float v[8]; float mx = -3.0e38f;
#pragma unroll
    for (int idx = 0; idx < 8; ++idx) { v[idx] = sc[idx >> 2][idx & 3] * ATT_SCALE + bias[idx]; if ((okmask >> idx) & 1u) mx = fmaxf(mx, v[idx]); }
    mx = xmax<16>(mx); mx = xmax<32>(mx);
    if (!__all(mx <= st.m + 8.f)) { const float mnew = fmaxf(st.m, mx), alpha = __expf(st.m - mnew); st.m = mnew; st.l *= alpha;
#pragma unroll
        for (int dq = 0; dq < 4; ++dq)
#pragma unroll
            for (int par = 0; par < 2; ++par) st.o[dq][par] = st.o[dq][par] * alpha; }
    const float mcur = st.m;
    float ps = 0.f; f32x4 p0, p1;
#pragma unroll
    for (int idx = 0; idx < 8; ++idx) { const float p = ((okmask >> idx) & 1u) ? __expf(v[idx] - mcur) : 0.f; ps += p; if (idx < 4) p0[idx] = p; else p1[idx - 4] = p; }
    ps = xsum<16>(ps); ps = xsum<32>(ps);
    st.l += ps;
    const bf16x8 pb = pack_acc(p0, p1);
    __builtin_amdgcn_s_setprio(1);
#pragma unroll
    for (int dq = 0; dq < 4; ++dq)
#pragma unroll
        for (int par = 0; par < 2; ++par) st.o[dq][par] = mfma16(vf[dq][par], pb, st.o[dq][par]);
    __builtin_amdgcn_s_setprio(0);
}
__device__ __forceinline__ void attn_init(AttnState& st, bool has_sink, float sink) {
#pragma unroll
    for (int dq = 0; dq < 4; ++dq) { st.o[dq][0] = (f32x4){0.f, 0.f, 0.f, 0.f}; st.o[dq][1] = (f32x4){0.f, 0.f, 0.f, 0.f}; }
    st.m = has_sink ? sink : -1.0e30f; st.l = has_sink ? 1.f : 0.f;
}
__device__ __forceinline__ void attn_load_q(bf16x8 (&qf)[4], const bf16* qrow, int g) {
#pragma unroll
    for (int kk = 0; kk < 4; ++kk) qf[kk] = ld8(qrow + 32 * kk + 8 * g);
}
template <bool GATE>
__device__ __forceinline__ void attn_finish(const AttnState& st, const bf16x8 (&z)[4], bf16* orow, int g) {
    const float il = __builtin_amdgcn_rcpf(st.l);
#pragma unroll
    for (int dq = 0; dq < 4; ++dq) {
        u32x4 w;
#pragma unroll
        for (int r = 0; r < 4; ++r) { const float a = st.o[dq][0][r] * il * (GATE ? siluf(bf2f((unsigned short)z[dq][2 * r])) : 1.f), b = st.o[dq][1][r] * il * (GATE ? siluf(bf2f((unsigned short)z[dq][2 * r + 1])) : 1.f);
            w[r] = pk2(a, b); }
        *(u32x4*)(orow + 32 * dq + 8 * g) = w; }
}

constexpr int AT_RPB = 131072;
template <int MODE>
__device__ __forceinline__ void attn_unit(Frame& F, int eo, int u) {
    FRESH_IDS();
    TP_BEGIN(11)
    const int c = lane & 15, g = lane >> 4;
    const bf16* P = (const bf16*)(F.ws + WS_P);
    constexpr int LDP = (MODE < 2) ? LDP_E : LDP_O;
    int b, hq, m, nt, q0 = 0, rr = 0, jb = 0, rs0 = 0, rsw = 0, kvh = 0;
    const bf16* qrow; const bf16* zrow;
    if (MODE == 0 || MODE == 2) { b = u >> 4; hq = (u >> 1) & 7; m = b * 256 + (u & 1) * 128 + wave * 16 + c; nt = 4; }
    else if (MODE == 1) { b = u >> 6; hq = (u >> 3) & 7; q0 = (u & 7) * 128; m = MCTX + b * 1024 + q0 + wave * 16 + c;
        int t0 = q0 - 128; if (t0 < 0) t0 = 0; int t1 = q0 + 256; if (t1 > 1024) t1 = 1024; rs0 = t0; nt = 4 + (t1 - t0) / 64; }
    else { b = u >> 6; hq = (u >> 3) & 7; const int rp = u & 7; rr = 2 * rp + (wave >> 2); jb = wave & 3; m = MCTX + b * 1024 + rr * 64 + 16 * jb + c;
        rs0 = 2 * rp - 4; rs0 = rs0 < 0 ? 0 : (rs0 > 8 ? 8 : rs0); int rs1 = 2 * rp - 3; rs1 = rs1 < 0 ? 0 : (rs1 > 8 ? 8 : rs1);
        rsw = rr - 4; rsw = rsw < 0 ? 0 : (rsw > 8 ? 8 : rsw); nt = 4 + (rs1 + 8 - rs0); }
    if (MODE == 0) { kvh = hq >> 2; qrow = P + (size_t)m * LDP + E_QB + hq * 128; zrow = P + (size_t)m * LDP + E_ZB + hq * 128; }
    else if (MODE == 1) { kvh = hq >> 2; qrow = P + (size_t)m * LDP + E_QB + hq * 128; zrow = P + (size_t)m * LDP + E_ZB + hq * 128; }
    else { qrow = P + (size_t)m * LDP + O_QD + hq * 128; zrow = P + (size_t)m * LDP + O_ZD + hq * 128; }
    (void)kvh; (void)q0; (void)rr; (void)jb; (void)rsw;
    auto tile_ptr = [&](int t) -> const unsigned char* {
        if (MODE == 0) return F.ws + WS_TCTX + (size_t)((b * 2 + kvh) * 4 + t) * AT_TILE;
        if (MODE == 2) return F.ws + WS_TCTX + (size_t)((b * 8 + hq) * 4 + t) * AT_TILE;
        if (MODE == 1) return (t < 4) ? F.ws + WS_TCACHE_E + (size_t)(((eo * 4 + b) * 2 + kvh) * 4 + t) * AT_TILE
                                      : F.ws + WS_TLAT + (size_t)((b * 2 + kvh) * 16 + (rs0 >> 6) + (t - 4)) * AT_TILE;
        return (t < 4) ? F.ws + WS_TCACHE_O + (size_t)(((eo * 4 + b) * 8 + hq) * 4 + t) * AT_TILE
                       : F.ws + WS_TLAT + (size_t)((b * 8 + hq) * 16 + rs0 + (t - 4)) * AT_TILE; };
    auto tile_dma = [&](int t) { const unsigned char* src = tile_ptr(t); LAS unsigned char* dst = F.lds + (t & 3) * AT_TILE;
#pragma unroll
        for (int i = 0; i < 4; ++i) __builtin_amdgcn_global_load_lds((const unsigned*)(src + (wave + 8 * i) * 1024 + lane * 16), (LAS unsigned*)(dst + (wave + 8 * i) * 1024), 16, 0, 0); };
    asm volatile("s_waitcnt lgkmcnt(0)" ::: "memory");
    __builtin_amdgcn_s_barrier();
    asm volatile("" ::: "memory");
    tile_dma(0); tile_dma(1); tile_dma(2);
    bf16x8 qf[4]; attn_load_q(qf, qrow, g);
    bf16x8 zf[4];
#pragma unroll
    for (int dq = 0; dq < 4; ++dq) { if (MODE < 2) zf[dq] = ld8(zrow + 32 * dq + 8 * g); else zf[dq] = (bf16x8){0, 0, 0, 0, 0, 0, 0, 0}; }
    f32x4 rt4[2][4];
    if (MODE == 1) { const int tq = q0 + wave * 16 + c;
#pragma unroll
        for (int a = 0; a < 2; ++a)
#pragma unroll
            for (int k = 0; k < 4; ++k) rt4[a][k] = *(const f32x4*)((const float*)(F.ws + WS_ROPE) + ((a ? (tq & 63) : (tq >> 6)) * 32 + 8 * g) * 2 + 4 * k); }
    const float sinkv = (MODE < 2) ? F.in[16][eo * 8 + hq] : 0.f;
    if (MODE == 3) { float* rt = (float*)(F.smem + AT_RPB); for (int i = tid; i < 465; i += NTHREADS) rt[i] = F.in[22][(size_t)(eo * 8 + hq) * 465 + i]; }
    asm volatile("s_waitcnt vmcnt(0)" : "+v"(qf[0]), "+v"(qf[1]), "+v"(qf[2]), "+v"(qf[3]), "+v"(zf[0]), "+v"(zf[1]), "+v"(zf[2]), "+v"(zf[3]) :: "memory");
    if (MODE == 1) {
#pragma unroll
        for (int a = 0; a < 2; ++a) { u32x4 w1, w2;
#pragma unroll
            for (int k = 0; k < 4; ++k) { float y1[2], y2[2];
#pragma unroll
                for (int hh = 0; hh < 2; ++hh) { const int j = 2 * k + hh; const float cs = rt4[a][k][2 * hh], sn = rt4[a][k][2 * hh + 1];
                    const float x1 = bf2f((unsigned short)qf[2 * a][j]), x2 = bf2f((unsigned short)qf[2 * a + 1][j]); y1[hh] = x1 * cs - x2 * sn; y2[hh] = x2 * cs + x1 * sn; }
                w1[k] = pk2(y1[0], y1[1]); w2[k] = pk2(y2[0], y2[1]); }
            qf[2 * a] = __builtin_bit_cast(bf16x8, w1); qf[2 * a + 1] = __builtin_bit_cast(bf16x8, w2); }
    }
    AttnState st; attn_init(st, MODE < 2, sinkv);
#pragma unroll 1
    for (int t = 0; t < nt; ++t) {
        const int rem = nt - 1 - t;
        if (rem >= 2) asm volatile("s_waitcnt vmcnt(8)" ::: "memory"); else if (rem == 1) asm volatile("s_waitcnt vmcnt(4)" ::: "memory"); else asm volatile("s_waitcnt vmcnt(0)" ::: "memory");
        asm volatile("s_waitcnt lgkmcnt(0)" ::: "memory");
        __builtin_amdgcn_s_barrier();
        asm volatile("" ::: "memory");
        if (t + 3 < nt) tile_dma(t + 3);
        const unsigned char* buf = F.smem + (t & 3) * AT_TILE;
        if (MODE == 0 || MODE == 2 || t < 4) {
            const float zb[8] = {0.f, 0.f, 0.f, 0.f, 0.f, 0.f, 0.f, 0.f};
            attn_step(st, qf, buf, 0, zb, 0xffu, lane); attn_step(st, qf, buf, 1, zb, 0xffu, lane);
        } else if (MODE == 1) {
            int gg = g; asm volatile("" : "+v"(gg));
            const int tk0 = rs0 + 64 * (t - 4), tq = q0 + wave * 16 + c; const float zb[8] = {0.f, 0.f, 0.f, 0.f, 0.f, 0.f, 0.f, 0.f};
#pragma unroll
            for (int s = 0; s < 2; ++s) {
                const int ks = tk0 + 32 * s, tqw = q0 + wave * 16;
                if (ks > tqw + 15 + 128 || ks + 31 < tqw - 128) continue;
                unsigned ok = 0u;
#pragma unroll
                for (int idx = 0; idx < 8; ++idx) { const int dd = tq - (tk0 + 32 * s + 16 * (idx >> 2) + 4 * gg + (idx & 3)); if (dd <= 128 && dd >= -128) ok |= 1u << idx; }
                attn_step(st, qf, buf, s, zb, ok, lane); }
        } else {
            const int R_ = rs0 + t - 4;
            if (R_ >= rsw && R_ < rsw + 8) {
                int gg = g; asm volatile("" : "+v"(gg));
                const float* rp = (const float*)(F.smem + AT_RPB) + (R_ - rr + 7) * 31;
                const int qc = 16 * jb + c; int cstart = qc - 8; cstart = cstart < 0 ? 0 : (cstart > 48 ? 48 : cstart);
#pragma unroll
                for (int s = 0; s < 2; ++s) { if ((jb == 0 && s == 1) || (jb == 3 && s == 0)) continue;
                    float bias[8]; unsigned ok = 0u;
#pragma unroll
                    for (int idx = 0; idx < 8; ++idx) { const int kcol = 32 * s + 16 * (idx >> 2) + 4 * gg + (idx & 3); int dc = kcol - qc; dc = dc < -15 ? -15 : (dc > 15 ? 15 : dc);
                        bias[idx] = rp[dc + 15]; if (kcol >= cstart && kcol < cstart + 16) ok |= 1u << idx; }
                    attn_step(st, qf, buf, s, bias, ok, lane); }
            }
        }
    }
    attn_finish<(MODE < 2)>(st, zf, (bf16*)(F.ws + WS_OMIX) + (size_t)m * DM + 1024 + hq * 128, g);
    if (MODE == 1) { TP_END(11) }
}

constexpr int N_PHASES = 26;

__device__ __forceinline__ void phase_gemm_in(Frame& F, int li) {
    unsigned char* ws = F.ws; asm volatile("" : "+s"(ws));
    const int e = li >> 1; const bool odd = li & 1;
    const int NP = odd ? NP_O : NP_E, LDP = odd ? LDP_O : LDP_E;
    const bf16* WT = (const bf16*)(ws + (odd ? WS_WIN_O + e * WIN_O_BYTES : WS_WIN_E + e * WIN_E_BYTES));
    pg8::Gemm gm{(const pg8::bf16_t*)(ws + WS_H), (const pg8::bf16_t*)WT, MROWS, NP, DM};
#ifdef TPROBE
    if (TPROBE == 401) gm.tp = (unsigned long long*)(ws + WS_CTL + 768 * 1024);
#endif
    pg8::SubsetOrder S; S.init(MROWS, 24 * 256, F.G, F.bid); S.odd = odd ? 1 : 0;
    pg8::EpiInProj E{(pg8::bf16_t*)(ws + WS_P), LDP, (float*)(ws + WS_SM), NP / 256 - 1};
    pg8::gemm_phase<pg8::EpiInProj, pg8::SubsetOrder, true, true>(F.lds, gm, S, E);
}
__device__ __forceinline__ void gemm_in_tile(Frame& F, int li, int idx) {
    unsigned char* ws = F.ws; asm volatile("" : "+s"(ws));
    const int e = li >> 1; const bool odd = li & 1;
    const int NP = odd ? NP_O : NP_E, LDP = odd ? LDP_O : LDP_E;
    const bf16* WT = (const bf16*)(ws + (odd ? WS_WIN_O + e * WIN_O_BYTES : WS_WIN_E + e * WIN_E_BYTES));
    pg8::Gemm gm{(const pg8::bf16_t*)(ws + WS_H), (const pg8::bf16_t*)WT, MROWS, NP, DM};
    pg8::SingleOrder S; if (odd) { const int j = idx % 5; S.pm = idx / 5; S.pn = (j < 4) ? 8 + j : 24; } else { S.pm = idx / 3; S.pn = 12 + idx % 3; }
    pg8::EpiInProj E{(pg8::bf16_t*)(ws + WS_P), LDP, (float*)(ws + WS_SM), NP / 256 - 1};
    __syncthreads();
    TP_BEGIN(12)
    pg8::gemm_phase<pg8::EpiInProj, pg8::SingleOrder, true, true>(F.lds, gm, S, E);
    TP_END(12)
}
__device__ __forceinline__ void phase_gemm_out(Frame& F, int li) {
    unsigned char* ws = F.ws; asm volatile("" : "+s"(ws));
    pg8::Gemm gm{(const pg8::bf16_t*)(ws + WS_OMIX), (const pg8::bf16_t*)(ws + WS_WOUT + li * WOUT_BYTES), MROWS, DM, DM};
#ifdef TPROBE
    if (TPROBE == 400) gm.tp = (unsigned long long*)(ws + WS_CTL + 768 * 1024);
#endif
    pg8::StaticOrder S; S.init(MROWS, DM, F.G, F.bid);
    pg8::EpiOutProj E{li == 0 ? F.in[0] : nullptr, li == 0 ? F.in[1] : nullptr, (pg8::bf16_t*)(ws + WS_X), (const float*)(ws + WS_MOD) + (size_t)li * 5 * 6144 + 4096};
    pg8::gemm_phase<pg8::EpiOutProj, pg8::StaticOrder, true, true>(F.lds, gm, S, E);
}
__device__ __forceinline__ void phase_prep(Frame& F, int li) {
    const int e = li >> 1;
    if (li & 1) { for (int u = F.bid; u < 512; u += F.G) gla_prep_unit(F, e, u >> 2, u & 3); }
    else {
        if (F.bid < 1024) { int tidf = F.tid; asm volatile("" : "+v"(tidf));
            delta_conv_weights(F, e, F.bid & 7, tidf);
            ConvIn C; delta_conv_load(F, C, e, F.bid >> 3, F.bid & 7, tidf);
            for (int u = F.bid; u < 1024; u += F.G) { const int un = u + F.G; delta_prep_unit(F, e, u >> 3, u & 7, C, (un < 1024 && (un & 7) == (u & 7)) ? (un >> 3) : -1);
                if (un < 1024 && (un & 7) != (u & 7)) { int t2 = F.tid; asm volatile("" : "+v"(t2)); __syncthreads(); delta_conv_weights(F, e, un & 7, t2); delta_conv_load(F, C, e, un >> 3, un & 7, t2); } } }
    }
    { TP_BEGIN(9)
    kv_tiles(F, li);
    TP_END(9) }
}
__device__ __forceinline__ int queue_fetch(unsigned* ctr) { return (int)__hip_atomic_fetch_add(ctr, 1u, __ATOMIC_RELAXED, __HIP_MEMORY_SCOPE_AGENT); }
__device__ __forceinline__ void phase_scan_attn(Frame& F, int li, int part, int rep) {
    const int e = li >> 1;
    unsigned* ctr = (unsigned*)(F.ws + WS_CTL) + 1024 + 64 * (li * 2 + rep);
    const int NG = (li & 1) ? 160 : 96;
    volatile LAS int* slot = (volatile LAS int*)(F.lds + LDS_MISC + 64);
    int nxt = 0; if (F.tid == 0) nxt = queue_fetch(ctr);
    for (int k = 0;; ++k) {
        if (F.tid == 0) slot[k & 1] = nxt;
        asm volatile("s_waitcnt lgkmcnt(0)" ::: "memory");
        __builtin_amdgcn_s_barrier();
        asm volatile("" ::: "memory");
        int u = slot[k & 1];
        if (F.tid == 0) nxt = queue_fetch(ctr);
        if (u >= 832 + NG) break;
#ifdef TPROBE
        unsigned long long tq0 = 0; if (TPROBE >= 300 && threadIdx.x == 0) tq0 = __builtin_amdgcn_s_memrealtime();
        const int uu = (u < 64) ? 0 : (u < 64 + NG) ? 1 : (u < 64 + NG + 256) ? 2 : (u < 64 + NG + 512) ? 3 : 4;
#endif
        if (u >= 64 && u < 64 + NG) { if (part == 0) gemm_in_tile(F, li, u - 64); }
        else { if (u >= 64) u -= NG;
        if (li & 1) {
            if (u < 64) { if (part != 2) gla_scan_unit(F, e, 128 + (u >> 1), u & 1); }
            else if (u < 320) { if (part != 1) attn_unit<3>(F, e, u - 64); }
            else if (u < 576) { if (part != 2) { const int cu = u - 320; gla_scan_unit(F, e, cu >> 1, cu & 1); } }
            else { if (part != 1) attn_unit<2>(F, e, u - 576); }
        } else {
            if (u < 64) { if (part != 2) delta_scan_unit(F, e, 256 + u); }
            else if (u < 320) { if (part != 1) attn_unit<1>(F, e, u - 64); }
            else if (u < 576) { if (part != 2) delta_scan_unit(F, e, u - 320); }
            else { if (part != 1) attn_unit<0>(F, e, u - 576); }
        } }
#ifdef TPROBE
        if (TPROBE >= 300 && threadIdx.x == 0 && TPROBE - 300 == 5 * (li & 1) + uu) atomicAdd((unsigned long long*)(F.ws + WS_CTL + 768 * 1024), __builtin_amdgcn_s_memrealtime() - tq0);
#endif
    }
}

#define XB_TMO      128
#define XB_XCNT(j)  (256  + 64 * (j))
#define XB_XSUB(j)  (1280 + 64 * (j))
#define XB_XGEN(j)  (2304 + 64 * (j))
#define XB_TOP      3328
#define XB_TOPGEN   3392
#define XCD_BAR_WORDS 3456
#define XB_SPIN_CAP (1u << 18)

__device__ __forceinline__ unsigned xb_ld(unsigned* p)              { return __hip_atomic_load(p, __ATOMIC_RELAXED, __HIP_MEMORY_SCOPE_AGENT); }
__device__ __forceinline__ unsigned xb_add(unsigned* p, unsigned v) { return __hip_atomic_fetch_add(p, v, __ATOMIC_RELAXED, __HIP_MEMORY_SCOPE_AGENT); }
__device__ __forceinline__ unsigned xb_xcc_id() { return (unsigned)__builtin_amdgcn_s_getreg((3 << 11) | 20) & 0xFu; }
#define XB_SPIN(cond, bar) do { unsigned _sp = 0; while (cond) { __builtin_amdgcn_s_sleep(1); \
    if ((++_sp & 255u) == 0u) { if (xb_ld(&(bar)[XB_TMO])) break; if (_sp > XB_SPIN_CAP) { atomicAdd(&(bar)[XB_TMO], 1u); break; } } } } while (0)

struct XcdBarrier {
    unsigned* bar; unsigned x;
    volatile LAS unsigned* st;
};

__device__ __forceinline__ XcdBarrier xcd_barrier_post(unsigned* bar, volatile LAS unsigned* st) {
    XcdBarrier b; b.bar = bar; b.x = xb_xcc_id(); b.st = st;
    if (threadIdx.x == 0) (void)xb_add(&bar[XB_XCNT(b.x)], 1u);
    return b;
}
__device__ __forceinline__ void xcd_barrier_complete(unsigned* bar, unsigned x, unsigned& nloc, unsigned& nx) {
    const unsigned G = gridDim.x * gridDim.y * gridDim.z;
    unsigned sum, cnt, mine, sp = 0u;
    for (;;) {
        sum = 0u; cnt = 0u; mine = 0u;
#pragma unroll
        for (unsigned j = 0; j < 16; ++j) { const unsigned c = xb_ld(&bar[XB_XCNT(j)]); sum += c; cnt += (c > 0u) ? 1u : 0u; mine = (j == x) ? c : mine; }
        if (sum == G) break;
        __builtin_amdgcn_s_sleep(1);
        if ((++sp & 255u) == 0u) { if (xb_ld(&bar[XB_TMO])) break; if (sp > XB_SPIN_CAP) { atomicAdd(&bar[XB_TMO], 1u); break; } }
    }
    nloc = mine > 0u ? mine : 1u; nx = cnt > 0u ? cnt : 1u;
}

__device__ __forceinline__ void xcd_barrier(const XcdBarrier& b) {
    asm volatile("s_waitcnt vmcnt(0)" ::: "memory");
    __syncthreads();
    if (threadIdx.x == 0) {
        unsigned* bar = b.bar;
        __builtin_amdgcn_s_waitcnt(0);
        unsigned nloc = b.st[0], nx = b.st[1];
        if (nloc == 0u) { xcd_barrier_complete(bar, b.x, nloc, nx); b.st[0] = nloc; b.st[1] = nx; }
        const unsigned old = xb_add(&bar[XB_XSUB(b.x)], 1u);
        const unsigned gen = old / nloc;
        if (old + 1u == (gen + 1u) * nloc) {
            __builtin_amdgcn_fence(__ATOMIC_RELEASE, "agent");
            asm volatile("s_waitcnt vmcnt(0)" ::: "memory");
            const unsigned og = xb_add(&bar[XB_TOP], 1u);
            const unsigned tg = og / nx;
            if (og + 1u == (tg + 1u) * nx) xb_add(&bar[XB_TOPGEN], 1u);
            else XB_SPIN(xb_ld(&bar[XB_TOPGEN]) == tg, bar);
            __builtin_amdgcn_fence(__ATOMIC_ACQUIRE, "agent");
            xb_add(&bar[XB_XGEN(b.x)], 1u);
            asm volatile("s_waitcnt vmcnt(0)" ::: "memory");
        } else {
            XB_SPIN(xb_ld(&bar[XB_XGEN(b.x)]) == gen, bar);
            __builtin_amdgcn_fence(__ATOMIC_ACQUIRE, "agent");
            asm volatile("s_waitcnt vmcnt(0)" ::: "memory");
        }
    }
    __syncthreads();
}


#ifdef NO_PRO
#define PH_PRO(x)
#else
#define PH_PRO(x) x
#endif
#ifdef NO_FN
#define PH_FN(x)
#else
#define PH_FN(x) x
#endif
#ifdef NO_NORM
#define PH_NORM(x)
#else
#define PH_NORM(x) x
#endif
#ifdef NO_GIN
#define PH_GIN(x)
#else
#define PH_GIN(x) x
#endif
#ifdef NO_PREP
#define PH_PREP(x)
#else
#define PH_PREP(x) x
#endif
#ifdef NO_SCAN
#define PH_SCAN(x)
#else
#define PH_SCAN(x) x
#endif
#ifdef NO_COMB
#define PH_COMB(x)
#else
#define PH_COMB(x) x
#endif
#ifdef NO_GOUT
#define PH_GOUT(x)
#else
#define PH_GOUT(x) x
#endif
__global__ void __launch_bounds__(NTHREADS, 2) fwd_kernel(Args args) {
    extern __shared__ __attribute__((aligned(16))) unsigned char lds_raw[];
    Frame F;
    F.lds = (LAS unsigned char*)lds_raw; F.smem = lds_raw;
    F.tid = threadIdx.x; F.G = gridDim.x; F.bid = blockIdx.x; F.in = args.in;
    F.out = args.out; F.ws = args.ws;
    for (int u = F.tid; u < 64; u += NTHREADS) ((LAS unsigned*)(F.lds + LDS_MISC))[u] = 0u;
    __syncthreads();
    XcdBarrier bar = xcd_barrier_post((unsigned*)(F.ws + WS_CTL) + 4096, (volatile LAS unsigned*)(F.lds + LDS_MISC) + 8);
#pragma unroll 1
    for (int ph = args.ph_lo; ph < args.ph_hi; ++ph) {
        int nrep = 1;
#ifndef DUP_PART
#define DUP_PART 0
#endif
#ifndef DUP_LAYERS
#define DUP_LAYERS 15
#endif
#ifdef DUP_SUB
        if (DUP_SUB == 6) { if (ph == 0) nrep = 2; }
        else if (ph > 0 && ph < N_PHASES - 1 && (ph - 1) % 6 == DUP_SUB && (DUP_SUB != 5 || ph == 6) && ((DUP_LAYERS >> ((ph - 1) / 6)) & 1)) nrep = 2;
#endif
#ifdef TPROBE
#ifndef TPLAYERS
#define TPLAYERS 15
#endif
        unsigned long long tpa = 0, tpb = 0;
        const bool tpsel = (TPROBE >= 100) && (TPROBE < 300) && threadIdx.x == 0 && ((TPROBE % 100 == 50) || (TPROBE % 100 == 6 && ph == 0) || (TPROBE % 100 == 7 && ph == N_PHASES - 1) ||
                            (ph > 0 && ph < N_PHASES - 1 && ((ph - 1) % 6 == (TPROBE % 100)) && ((TPLAYERS >> ((ph - 1) / 6)) & 1)));
        if (tpsel) tpa = __builtin_amdgcn_s_memrealtime();
#endif
#pragma unroll 1
        for (int rep = 0; rep < nrep; ++rep) {
        if (rep) xcd_barrier(bar);
        if (ph == 0) { PH_PRO(phase_prologue(F); rope_table(F); cache_tiles(F)); }
        else if (ph == N_PHASES - 1) { PH_FN(phase_final_norm(F)); }
        else { const int li = (ph - 1) / 6, sub = (ph - 1) % 6;
            if (sub == 0) { PH_NORM(phase_norm(F, li)); }
            else if (sub == 1) { PH_GIN(phase_gemm_in(F, li)); }
            else if (sub == 2) { PH_PREP(phase_prep(F, li)); }
            else if (sub == 3) { PH_SCAN(phase_scan_attn(F, li, rep ? DUP_PART : 0, rep)); }
            else if (sub == 4) { PH_COMB(if (li & 1) phase_combine_odd(F, li >> 1); else phase_combine_even(F, li >> 1)); }
            else { PH_GOUT(phase_gemm_out(F, li)); }
        }
        }
#ifdef TPROBE
        __syncthreads();
        if (tpsel) tpb = __builtin_amdgcn_s_memrealtime();
#endif
        if (ph + 1 < args.ph_hi) { if (args.pad != 0) cg::this_grid().sync();
            xcd_barrier(bar); }
        __syncthreads();
#ifdef TPROBE
        if (tpsel) { const unsigned long long tpc = __builtin_amdgcn_s_memrealtime();
            atomicAdd((unsigned long long*)(F.ws + WS_CTL + 768 * 1024), (TPROBE == 150) ? (tpc - tpa) : (TPROBE >= 200) ? (tpc - tpb) : (tpb - tpa)); }
#endif
    }
}

extern "C" void kernel_launch(void* const* d_in, const int* in_sizes, int n_in, void* d_out, int out_size, void* d_ws, size_t ws_size, hipStream_t stream) {
    static int grid = 0;
    if (grid == 0) {
        if (n_in != 25 || (size_t)out_size != OUT_TOTAL || ws_size < WS_END) { fprintf(stderr, "kernel_launch: unexpected problem (n_in %d, out %d, ws %zu)\n", n_in, out_size, ws_size); grid = -1; return; }
        int dev = 0, cus = 0;
        if (hipGetDevice(&dev) != hipSuccess || hipDeviceGetAttribute(&cus, hipDeviceAttributeMultiprocessorCount, dev) != hipSuccess) { grid = -1; return; }
        if (hipFuncSetAttribute((const void*)fwd_kernel, hipFuncAttributeMaxDynamicSharedMemorySize, LDS_BYTES) != hipSuccess) { fprintf(stderr, "kernel_launch: hipFuncSetAttribute failed\n"); grid = -1; return; }
        int per_cu = 0;
        if (hipOccupancyMaxActiveBlocksPerMultiprocessor(&per_cu, (const void*)fwd_kernel, NTHREADS, LDS_BYTES) != hipSuccess || per_cu < 1) { fprintf(stderr, "kernel_launch: occupancy query says %d\n", per_cu); (void)hipGetLastError(); }
        if (per_cu < 1) per_cu = 1;
        grid = cus * 1;
    }
    if (grid < 0) return;
    (void)hipMemsetAsync((char*)d_ws + WS_CTL, 0, CTL_ZERO_BYTES, stream);
    Args a{};
    for (int i = 0; i < 25; ++i) a.in[i] = (const float*)d_in[i];
    a.out = (float*)d_out; a.ws = (unsigned char*)d_ws; a.coop = 1; a.pad = 0;
    a.ph_lo = 0; a.ph_hi = N_PHASES;
    void* kargs[] = {&a};
    hipError_t e = hipLaunchCooperativeKernel((const void*)fwd_kernel, dim3(grid), dim3(NTHREADS), kargs, LDS_BYTES, stream);
    if (e != hipSuccess) fprintf(stderr, "kernel_launch: cooperative launch failed: %s (grid %d)\n", hipGetErrorString(e), grid);
}
```
